# Optimizing an MI355X kernel written in HIP

```python
import jax, jax.numpy as jnp
from jax import lax
import numpy as np

D_MODEL = 1024
BATCH = 2
SEQ = 8192
DEPTH = 1

CONV_WIDTH = D_MODEL
CONV_K = 3
RET_HEADS = 4
RET_QK_DIM = D_MODEL // RET_HEADS
RET_V_DIM = 2 * RET_QK_DIM
RET_QK = RET_HEADS * RET_QK_DIM
RET_V = RET_HEADS * RET_V_DIM
CHUNK = 128
ROPE_BASE = 10000.0
D_FF = -(-8 * D_MODEL // (3 * 256)) * 256
EPS = 1e-6
IN_SIZES = (CONV_WIDTH, CONV_WIDTH, CONV_WIDTH, RET_QK, RET_QK, RET_V, RET_V, D_MODEL, D_MODEL)
N_IN = sum(IN_SIZES)

kernel_name = "hybrid_shortconv_retention_gated_block"


def rmsnorm(x, g):
    xf = x.astype(jnp.float32)
    y = xf * lax.rsqrt(jnp.mean(xf * xf, axis=-1, keepdims=True) + EPS)
    return (y * g.astype(jnp.float32)).astype(x.dtype)


def rotary(t):
    s, d = t.shape[1], t.shape[-1]
    pos = jnp.arange(s, dtype=jnp.float32)
    freqs = ROPE_BASE ** (-jnp.arange(0, d, 2, dtype=jnp.float32) / d)
    ang = pos[:, None] * freqs[None, :]
    cos = jnp.cos(ang)[None, :, None, :]
    sin = jnp.sin(ang)[None, :, None, :]
    t1, t2 = t[..., : d // 2], t[..., d // 2:]
    return jnp.concatenate([t1 * cos - t2 * sin, t1 * sin + t2 * cos], axis=-1)


def retention_chunkwise(q, k, v, log_gamma, strict):
    b, h, s, dk = q.shape
    dv = v.shape[-1]
    n_chunks = s // CHUNK

    def chunks(t):
        return jnp.moveaxis(t.reshape(b, h, n_chunks, CHUNK, t.shape[-1]), 2, 0)

    idx = jnp.arange(CHUNK, dtype=jnp.float32)
    diff = idx[:, None] - idx[None, :]
    mask = (diff > 0) if strict else (diff >= 0)
    lg = log_gamma[:, None, None]
    intra_decay = jnp.where(mask[None], jnp.exp(jnp.maximum(diff, 0.0)[None] * lg), 0.0)
    xi = jnp.exp((idx + 1.0)[None, :] * log_gamma[:, None])[..., None]
    zeta = jnp.exp((CHUNK - 1.0 - idx)[None, :] * log_gamma[:, None])[..., None]
    chunk_decay = jnp.exp(CHUNK * log_gamma)[:, None, None]

    def step(state, qkv):
        qc, kc, vc = qkv
        scores = jnp.einsum('bhcd,bhmd->bhcm', qc, kc) * intra_decay
        inner = jnp.einsum('bhcm,bhme->bhce', scores, vc)
        cross = jnp.einsum('bhcd,bhde->bhce', qc, state) * xi
        state = chunk_decay * state + jnp.einsum('bhcd,bhce->bhde', kc * zeta, vc)
        return state, inner + cross

    state0 = jnp.zeros((b, h, dk, dv), jnp.float32)
    _, out = lax.scan(step, state0, (chunks(q), chunks(k), chunks(v)))
    return jnp.moveaxis(out, 0, 2).reshape(b, h, s, dv)


def setup_inputs(seed: int = 0) -> dict:
    key = jax.random.key(seed)
    ks = jax.random.split(key, 16)
    f32 = jnp.float32

    def normal(k, shape, scale):
        return jax.random.normal(k, shape, f32) * scale

    def gain(k, shape):
        return 1.0 + 0.05 * jax.random.normal(k, shape, f32)

    base_logit = jnp.log(2.0 ** (5.0 + jnp.arange(RET_HEADS, dtype=f32)) - 1.0)
    return {
        "x": jax.random.normal(ks[0], (BATCH, SEQ, D_MODEL), f32),
        "g_mix": gain(ks[1], (DEPTH, D_MODEL)),
        "w_in": normal(ks[2], (DEPTH, D_MODEL, N_IN), D_MODEL ** -0.5),
        "w_conv": normal(ks[3], (DEPTH, CONV_K, CONV_WIDTH), CONV_K ** -0.5),
        "dec_f": base_logit[None] + 0.01 * jax.random.normal(ks[4], (DEPTH, RET_HEADS), f32),
        "dec_b": base_logit[None] + 0.01 * jax.random.normal(ks[5], (DEPTH, RET_HEADS), f32),
        "g_ret": gain(ks[6], (DEPTH, RET_V)),
        "w_a_out": normal(ks[7], (DEPTH, CONV_WIDTH, D_MODEL), CONV_WIDTH ** -0.5),
        "w_r_out": normal(ks[8], (DEPTH, RET_V, D_MODEL), RET_V ** -0.5),
        "w_o": normal(ks[9], (DEPTH, D_MODEL, D_MODEL), D_MODEL ** -0.5),
        "g_ffn": gain(ks[10], (DEPTH, D_MODEL)),
        "w_ff_gate": normal(ks[11], (DEPTH, D_MODEL, D_FF), D_MODEL ** -0.5),
        "w_ff_up": normal(ks[12], (DEPTH, D_MODEL, D_FF), D_MODEL ** -0.5),
        "w_ff_down": normal(ks[13], (DEPTH, D_FF, D_MODEL), D_FF ** -0.5),
        "g_final": gain(ks[14], (D_MODEL,)),
    }


def reference(x, g_mix, w_in, w_conv, dec_f, dec_b, g_ret, w_a_out, w_r_out, w_o,
              g_ffn, w_ff_gate, w_ff_up, w_ff_down, g_final):
    b, s, _ = x.shape
    dt = x.dtype
    split_points = [int(p) for p in np.cumsum(IN_SIZES)[:-1]]
    for l in range(DEPTH):
        h = rmsnorm(x, g_mix[l])
        proj = h @ w_in[l]
        xc, gb, gc, q, k, v, g_sw, gate_a, gate_r = jnp.split(proj, split_points, axis=-1)

        u = gc * xc
        u_pad = jnp.pad(u, ((0, 0), (CONV_K // 2, CONV_K // 2), (0, 0)))
        conv = u_pad[:, 0:s] * w_conv[l, 0]
        for tap in range(1, CONV_K):
            conv = conv + u_pad[:, tap:tap + s] * w_conv[l, tap]
        y_a = (gb * conv) @ w_a_out[l]

        qf = rotary(q.reshape(b, s, RET_HEADS, RET_QK_DIM).astype(jnp.float32)) * (RET_QK_DIM ** -0.5)
        kf = rotary(k.reshape(b, s, RET_HEADS, RET_QK_DIM).astype(jnp.float32))
        vf = v.reshape(b, s, RET_HEADS, RET_V_DIM).astype(jnp.float32)
        qf, kf, vf = (jnp.transpose(t, (0, 2, 1, 3)) for t in (qf, kf, vf))
        lg_f = jax.nn.log_sigmoid(dec_f[l].astype(jnp.float32))
        lg_b = jax.nn.log_sigmoid(dec_b[l].astype(jnp.float32))
        ret_f = retention_chunkwise(qf, kf, vf, lg_f, strict=False)
        ret_b = jnp.flip(retention_chunkwise(jnp.flip(qf, 2), jnp.flip(kf, 2), jnp.flip(vf, 2),
                                             lg_b, strict=True), 2)
        ret = ret_f + ret_b
        mu = jnp.mean(ret, axis=-1, keepdims=True)
        var = jnp.mean(jnp.square(ret - mu), axis=-1, keepdims=True)
        ret = (ret - mu) * lax.rsqrt(var + EPS)
        ret = jnp.transpose(ret, (0, 2, 1, 3)).reshape(b, s, RET_V) * g_ret[l].astype(jnp.float32)
        y_r = (ret.astype(dt) * jax.nn.silu(g_sw)) @ w_r_out[l]

        merged = jax.nn.sigmoid(gate_a) * y_a + jax.nn.sigmoid(gate_r) * y_r
        x = x + merged @ w_o[l]

        h2 = rmsnorm(x, g_ffn[l])
        x = x + (jax.nn.silu(h2 @ w_ff_gate[l]) * (h2 @ w_ff_up[l])) @ w_ff_down[l]
    return rmsnorm(x, g_final)
```

```cpp
#include <hip/hip_runtime.h>
#include <cstdio>
#include <cstdint>

#define GAS __attribute__((address_space(1)))
#define LAS __attribute__((address_space(3)))
typedef unsigned short bf16_t;
typedef short bf16x8 __attribute__((ext_vector_type(8)));
typedef float f32x4 __attribute__((ext_vector_type(4)));
typedef float f32x16 __attribute__((ext_vector_type(16)));
typedef unsigned u32x4 __attribute__((ext_vector_type(4)));
typedef unsigned u32x2 __attribute__((ext_vector_type(2)));
typedef float f32x2_t __attribute__((ext_vector_type(2)));
typedef __bf16 bf16x2_t __attribute__((ext_vector_type(2)));
typedef GAS unsigned gu32;

constexpr int BATCH = 2, SEQ = 8192, D = 1024, M = BATCH * SEQ, NIN = 11264, DFF = 2816;
constexpr int NH = 4, DK = 256, DV = 512, CH = 128, NCH = SEQ / CH, NGC = M / CH;
constexpr float EPS = 1e-6f;
constexpr int NWAVES = 8, NTHREADS = 512;

__device__ __forceinline__ unsigned cvtpk(float lo, float hi) { f32x2_t v = {lo, hi}; bf16x2_t b = __builtin_convertvector(v, bf16x2_t); return __builtin_bit_cast(unsigned, b); }
__device__ __forceinline__ float bflo(unsigned u) { return __uint_as_float(u << 16); }
__device__ __forceinline__ float bfhi(unsigned u) { return __uint_as_float(u & 0xffff0000u); }
__device__ __forceinline__ float sigmoidf_(float x) { return 1.0f / (1.0f + __expf(-x)); }
__device__ __forceinline__ float siluf_(float x) { return x / (1.0f + __expf(-x)); }
__device__ __forceinline__ float wave_sum(float v) {
#pragma unroll
    for (int o = 1; o < 64; o <<= 1) v += __shfl_xor(v, o);
    return v;
}
__device__ __forceinline__ int lane_id() { int l; asm volatile("v_mbcnt_lo_u32_b32 %0, -1, 0\n\tv_mbcnt_hi_u32_b32 %0, -1, %0" : "=v"(l)); return l; }
__device__ __forceinline__ int opaque_tid(int wave_s) { int t = wave_s * 64 + lane_id(); asm volatile("" : "+v"(t)); return t; }
#define LDS_WAIT() asm volatile("s_waitcnt lgkmcnt(0)" ::: "memory")
#define VM_WAIT() asm volatile("s_waitcnt vmcnt(0)" ::: "memory")
#define RLX_AGENT __ATOMIC_RELAXED, __HIP_MEMORY_SCOPE_AGENT

namespace pg8 {
constexpr int BM = 256, BK = 64, HALF = 128, HTB = HALF * BK * 2, STAGE_BYTES = 8 * HTB, NXCD = 8, WGM = 8;
__host__ __device__ __forceinline__ int lds_byte(int r, int c) { const int st = (r >> 4) * 2 + (c >> 5), rr = r & 15, cc = c & 31, ob = rr * 64 + cc * 2; return st * 1024 + (ob ^ (((ob >> 9) & 1) << 5)); }
__host__ __device__ __forceinline__ void stage_rc(int b, int& R, int& C) { const int st = b / 1024, sb = b % 1024, swz = sb ^ (((sb >> 9) & 1) << 5); R = (st >> 1) * 16 + swz / 64; C = (st & 1) * 32 + (swz % 64) / 2; }
__host__ __device__ __forceinline__ int perm32(int rho) { const int n = rho >> 4, i = rho & 15; return 8 * (i >> 2) + 4 * n + (i & 3); }

struct Unit { int pm, pn; };
struct Gemm { const bf16_t* A1; int lda1; int nt1; const bf16_t* A2; const bf16_t* Bt; int M, N, K; };

struct StaticOrder {
    int nM, nN, nwg, G, c;
    __device__ void init(int M_, int N_, int G_, int c_) { nM = M_ / BM; nN = N_ / BM; nwg = nM * nN; G = G_; c = c_; }
    __device__ bool next(int i, Unit& u) const {
        const long L = (long)i * G + c; if (L >= nwg) return false;
        int wgid = (int)L; { const int q = nwg / NXCD, r = nwg % NXCD, xcd = wgid % NXCD, off = wgid / NXCD; wgid = (xcd < r ? xcd * (q + 1) : r * (q + 1) + (xcd - r) * q) + off; }
        const int nig = WGM * nN, gid = wgid / nig, fm = gid * WGM, gsz = (nM - fm) < WGM ? (nM - fm) : WGM;
        u.pm = fm + ((wgid % nig) % gsz); u.pn = (wgid % nig) / gsz; return true;
    }
};

template <class Epi, class Sched>
__device__ __forceinline__ void gemm_phase(LAS unsigned char* lds, const Gemm g, const Sched& S, const Epi& E, int wave_s) {
    const int tid = opaque_tid(wave_s), wid = wave_s, lane = tid & 63, wr = wid >> 2, wc = wid & 3, fr = lane & 15, fq = lane >> 4;
    const int K = g.K, nt = K / BK, nt1 = g.nt1;
    unsigned voffA[2], voffA2[2], voffB[2];
#pragma unroll
    for (int i = 0; i < 2; ++i) { int R, C; stage_rc(tid * 16 + i * 8192, R, C); const int Rb = (R & ~31) + perm32(R & 31);
        voffA[i] = (unsigned)(R * g.lda1 + C) * 2u; voffB[i] = (unsigned)(Rb * K + C) * 2u;
        voffA2[i] = (unsigned)((C >> 5) * 4096 + (R >> 5) * 1024 + (R & 31) * 32 + (C & 31)) * 2u; }
    const size_t hs1 = (size_t)HALF * g.lda1 * 2, hs2 = (size_t)64 * 4096 * 2;
    const size_t hsB = (size_t)HALF * K * 2;
    const uintptr_t a1base = (uintptr_t)g.A1, a2base = (uintptr_t)g.A2;
    const unsigned ldsw = (unsigned)wid * 1024u;
    const int aoff = lds_byte(wr * 64 + fr, fq * 8), boff = lds_byte(wc * 32 + fr, fq * 8);
#define PG8_SA(b, h) (((b) * 2 + (h)) * HTB)
#define PG8_SB(b, h) ((4 + (b) * 2 + (h)) * HTB)
#define PG8_GLDS(gp, slot, i) __builtin_amdgcn_global_load_lds((const unsigned*)(gp), (LAS unsigned*)(lds + (slot) + ldsw + (i) * 8192), 16, 0, 0)
#define PG8_STAGE_A(slot, pm_, t_, hf) do { const int _t = (t_); const bool _s1 = _t < nt1; \
        const uintptr_t _gb = _s1 ? a1base + (size_t)(2 * (pm_) + (hf)) * hs1 + (size_t)_t * 128 \
                                  : a2base + (size_t)(2 * (pm_) + (hf)) * hs2 + (size_t)(_t - nt1) * 16384; \
        const unsigned _v0 = _s1 ? voffA[0] : voffA2[0], _v1 = _s1 ? voffA[1] : voffA2[1]; \
        PG8_GLDS(_gb + _v0, slot, 0); PG8_GLDS(_gb + _v1, slot, 1); } while (0)
#define PG8_STAGE_B(slot, pn_, t_, hf) do { const char* _gb = (const char*)g.Bt + (size_t)(pn_) * 2 * hsB + (size_t)(hf) * hsB + (size_t)(t_) * 128; \
        PG8_GLDS(_gb + voffB[0], slot, 0); PG8_GLDS(_gb + voffB[1], slot, 1); } while (0)
#define PG8_LDA(dst, b, h) do { _Pragma("unroll") for (int m = 0; m < 4; ++m) _Pragma("unroll") for (int k = 0; k < 2; ++k) dst[m][k] = *(const LAS bf16x8*)(lds + PG8_SA(b, h) + aoff + m * 2048 + k * 1024); } while (0)
#define PG8_LDB(dst, b, h) do { _Pragma("unroll") for (int n = 0; n < 2; ++n) _Pragma("unroll") for (int k = 0; k < 2; ++k) dst[n][k] = *(const LAS bf16x8*)(lds + PG8_SB(b, h) + boff + n * 2048 + k * 1024); } while (0)
#define PG8_MMA(ai, bj, At, Bt) do { __builtin_amdgcn_s_setprio(1); _Pragma("unroll") for (int m = 0; m < 4; ++m) _Pragma("unroll") for (int n = 0; n < 2; ++n) _Pragma("unroll") for (int k = 0; k < 2; ++k) \
        acc[ai][bj][m][n] = __builtin_amdgcn_mfma_f32_16x16x32_bf16(Bt[n][k], At[m][k], acc[ai][bj][m][n], 0, 0, 0); __builtin_amdgcn_s_setprio(0); } while (0)
#define PG8_WAIT_V(n) asm volatile("s_waitcnt vmcnt(" #n ")" ::: "memory")
#define PG8_WAIT_L(n) asm volatile("s_waitcnt lgkmcnt(" #n ")" ::: "memory")
#define PG8_BAR __builtin_amdgcn_s_barrier()
#define PG8_SCHED __builtin_amdgcn_sched_barrier(0)
    Unit cur, nxt; int ui = 0;
    if (!S.next(0, cur)) return;
    f32x4 acc[2][2][4][2];
#pragma unroll
    for (int a = 0; a < 2; ++a)
#pragma unroll
        for (int b = 0; b < 2; ++b)
#pragma unroll
            for (int m = 0; m < 4; ++m)
#pragma unroll
                for (int n = 0; n < 2; ++n) acc[a][b][m][n] = (f32x4){0.f, 0.f, 0.f, 0.f};
    bf16x8 At[4][2], B0[2][2], B1[2][2];
    PG8_STAGE_B(PG8_SB(0, 0), cur.pn, 0, 0); PG8_STAGE_B(PG8_SB(0, 1), cur.pn, 0, 1); PG8_STAGE_A(PG8_SA(0, 0), cur.pm, 0, 0); PG8_STAGE_A(PG8_SA(0, 1), cur.pm, 0, 1);
    if (wr == 1) PG8_BAR;
    PG8_WAIT_V(2); PG8_BAR;
    PG8_STAGE_B(PG8_SB(1, 0), cur.pn, 1, 0); PG8_STAGE_A(PG8_SA(1, 0), cur.pm, 1, 0); PG8_STAGE_B(PG8_SB(1, 1), cur.pn, 1, 1);
    PG8_WAIT_V(6); PG8_BAR;
    for (;;) {
        const bool has_next = S.next(ui + 1, nxt);
        const int npm = has_next ? nxt.pm : cur.pm, npn = has_next ? nxt.pn : cur.pn;
        for (int t = 0; t < nt; t += 2) {
            const bool last = (t == nt - 2);
            const int pm2 = last ? npm : cur.pm, pn2 = last ? npn : cur.pn, t2 = last ? 0 : t + 2, t3 = t2 + 1;
            if constexpr (Epi::MID) { if (t == nt1 && nt1 < nt) { int fr_e = fr, fq_e = fq; asm volatile("" : "+v"(fr_e), "+v"(fq_e)); E.mid(acc, cur, wr, wc, fr_e, fq_e); } }
            PG8_LDB(B0, 0, 0); PG8_LDB(B1, 0, 1); PG8_SCHED; PG8_LDA(At, 0, 0); PG8_STAGE_A(PG8_SA(1, 1), cur.pm, t + 1, 1);
            PG8_WAIT_V(8); PG8_WAIT_L(0); PG8_BAR; PG8_MMA(0, 0, At, B0); PG8_MMA(0, 1, At, B1); PG8_BAR; PG8_SCHED;
            PG8_LDA(At, 0, 1); PG8_STAGE_B(PG8_SB(0, 0), pn2, t2, 0); PG8_STAGE_B(PG8_SB(0, 1), pn2, t2, 1); PG8_STAGE_A(PG8_SA(0, 0), pm2, t2, 0);
            PG8_WAIT_V(8); PG8_WAIT_L(0); PG8_BAR; PG8_MMA(1, 0, At, B0); PG8_MMA(1, 1, At, B1); PG8_BAR; PG8_SCHED;
            PG8_LDB(B0, 1, 0); PG8_LDB(B1, 1, 1); PG8_SCHED; PG8_LDA(At, 1, 0); PG8_STAGE_A(PG8_SA(0, 1), pm2, t2, 1);
            PG8_WAIT_V(8); PG8_WAIT_L(0); PG8_BAR; PG8_MMA(0, 0, At, B0); PG8_MMA(0, 1, At, B1); PG8_BAR; PG8_SCHED;
            PG8_LDA(At, 1, 1); PG8_STAGE_B(PG8_SB(1, 0), pn2, t3, 0); PG8_STAGE_B(PG8_SB(1, 1), pn2, t3, 1); PG8_STAGE_A(PG8_SA(1, 0), pm2, t3, 0);
            PG8_WAIT_V(8); PG8_WAIT_L(0); PG8_BAR; PG8_MMA(1, 0, At, B0); PG8_MMA(1, 1, At, B1); PG8_BAR; PG8_SCHED;
        }
        if (wr == 0) PG8_BAR;
        { int fr_e = fr, fq_e = fq; asm volatile("" : "+v"(fr_e), "+v"(fq_e));
          E(acc, cur, wr, wc, fr_e, fq_e); }
        if (!has_next) break;
#pragma unroll
        for (int a = 0; a < 2; ++a)
#pragma unroll
            for (int b = 0; b < 2; ++b)
#pragma unroll
                for (int m = 0; m < 4; ++m)
#pragma unroll
                    for (int n = 0; n < 2; ++n) acc[a][b][m][n] = (f32x4){0.f, 0.f, 0.f, 0.f};
        cur = nxt; ++ui;
        if (wr == 1) PG8_BAR;
    }
    PG8_WAIT_V(0);
    PG8_BAR;
#undef PG8_SA
#undef PG8_SB
#undef PG8_GLDS
#undef PG8_STAGE_A
#undef PG8_STAGE_B
#undef PG8_LDA
#undef PG8_LDB
#undef PG8_MMA
#undef PG8_WAIT_V
#undef PG8_WAIT_L
#undef PG8_BAR
#undef PG8_SCHED
}
}
__device__ __forceinline__ size_t qf_off(int m, int h, int d0  ) {
    const int gc = m >> 7, tt = (m >> 5) & 3, r = m & 31, kd = d0 >> 4, hh = (d0 >> 3) & 1;
    return ((((size_t)(gc * 4 + h) * 4 + tt) * 16 + kd) * 64 + hh * 32 + r) * 8;
}

struct EpiQK {
    static constexpr bool MID = false;
    bf16_t* QF; bf16_t* KF; const float* rstd; const float* CS; const float* SN;
    __device__ __forceinline__ void mid(f32x4 (&)[2][2][4][2], const pg8::Unit&, int, int, int, int) const {}
    __device__ __forceinline__ void operator()(const f32x4 (&acc)[2][2][4][2], const pg8::Unit& u, int wr, int wc, int fr, int fq) const {
        const bool isq = u.pn < 4; const int h = u.pn & 3; bf16_t* dst = isq ? QF : KF; const float osc = isq ? 0.0625f : 1.0f;
        const int jf0 = wc * 32 + 8 * fq;
#pragma unroll
        for (int ai = 0; ai < 2; ++ai)
#pragma unroll
            for (int m = 0; m < 4; ++m) {
                const int row = u.pm * 256 + ai * 128 + wr * 64 + m * 16 + fr, pos = row & (SEQ - 1);
                const float rs = rstd[row] * osc;
                const f32x4 c0 = *(const f32x4*)(CS + (size_t)pos * 128 + jf0), c1 = *(const f32x4*)(CS + (size_t)pos * 128 + jf0 + 4);
                const f32x4 s0 = *(const f32x4*)(SN + (size_t)pos * 128 + jf0), s1 = *(const f32x4*)(SN + (size_t)pos * 128 + jf0 + 4);
                const f32x4 a0 = acc[ai][0][m][0] * rs, a1 = acc[ai][0][m][1] * rs, b0 = acc[ai][1][m][0] * rs, b1 = acc[ai][1][m][1] * rs;
                const f32x4 o10 = a0 * c0 - b0 * s0, o11 = a1 * c1 - b1 * s1, o20 = a0 * s0 + b0 * c0, o21 = a1 * s1 + b1 * c1;
                u32x4 w1, w2;
                w1.x = cvtpk(o10[0], o10[1]); w1.y = cvtpk(o10[2], o10[3]); w1.z = cvtpk(o11[0], o11[1]); w1.w = cvtpk(o11[2], o11[3]);
                w2.x = cvtpk(o20[0], o20[1]); w2.y = cvtpk(o20[2], o20[3]); w2.z = cvtpk(o21[0], o21[1]); w2.w = cvtpk(o21[2], o21[3]);
                *(u32x4*)(dst + qf_off(row, h, jf0)) = w1;
                *(u32x4*)(dst + qf_off(row, h, 128 + jf0)) = w2;
            }
    }
};

struct EpiKVT {
    static constexpr bool MID = false;
    bf16_t* KT; bf16_t* VT; const float* rstd; const float* CST; const float* SNT;
    __device__ __forceinline__ void mid(f32x4 (&)[2][2][4][2], const pg8::Unit&, int, int, int, int) const {}
    __device__ __forceinline__ void operator()(const f32x4 (&acc)[2][2][4][2], const pg8::Unit& u, int wr, int wc, int fr, int fq) const {
        if (u.pm < 4) {
            const int h = u.pm;
#pragma unroll
            for (int bj = 0; bj < 2; ++bj) {
                const int tok0 = u.pn * 256 + bj * 128 + wc * 32 + 8 * fq, gc = tok0 >> 7, s0 = tok0 & 127, pos0 = tok0 & (SEQ - 1);
                const int ks = s0 >> 4, jhi = (s0 >> 3) & 1;
                const f32x4 r0 = *(const f32x4*)(rstd + tok0), r1 = *(const f32x4*)(rstd + tok0 + 4);
#pragma unroll
                for (int m = 0; m < 4; ++m) {
                    const int jf = wr * 64 + m * 16 + fr;
                    const f32x4 c0 = *(const f32x4*)(CST + (size_t)jf * SEQ + pos0), c1 = *(const f32x4*)(CST + (size_t)jf * SEQ + pos0 + 4);
                    const f32x4 s0v = *(const f32x4*)(SNT + (size_t)jf * SEQ + pos0), s1v = *(const f32x4*)(SNT + (size_t)jf * SEQ + pos0 + 4);
                    const f32x4 a0 = acc[0][bj][m][0] * r0, a1 = acc[0][bj][m][1] * r1, b0 = acc[1][bj][m][0] * r0, b1 = acc[1][bj][m][1] * r1;
                    const f32x4 o10 = a0 * c0 - b0 * s0v, o11 = a1 * c1 - b1 * s1v, o20 = a0 * s0v + b0 * c0, o21 = a1 * s1v + b1 * c1;
#pragma unroll
                    for (int half = 0; half < 2; ++half) {
                        const int d = half * 128 + jf, dt = d >> 5, dl = d & 31;
                        const size_t base = ((((size_t)(gc * 4 + h) * 8 + dt) * 8 + ks) * 64) * 8 + 4 * jhi;
                        const f32x4 v0 = half ? o20 : o10, v1 = half ? o21 : o11;
                        u32x2 w0, w1; w0.x = cvtpk(v0[0], v0[1]); w0.y = cvtpk(v0[2], v0[3]); w1.x = cvtpk(v1[0], v1[1]); w1.y = cvtpk(v1[2], v1[3]);
                        *(u32x2*)(KT + base + (size_t)(dl) * 8) = w0;
                        *(u32x2*)(KT + base + (size_t)(32 + dl) * 8) = w1;
                    }
                    asm volatile("" ::: "memory");
                }
            }
        } else {
#pragma unroll
            for (int bj = 0; bj < 2; ++bj) {
                const int tok0 = u.pn * 256 + bj * 128 + wc * 32 + 8 * fq, gc = tok0 >> 7, s0 = tok0 & 127;
                const int ks = s0 >> 4, jhi = (s0 >> 3) & 1;
                const f32x4 r0 = *(const f32x4*)(rstd + tok0), r1 = *(const f32x4*)(rstd + tok0 + 4);
#pragma unroll
                for (int ai = 0; ai < 2; ++ai)
#pragma unroll
                    for (int m = 0; m < 4; ++m) {
                        const int eg = (u.pm - 4) * 256 + ai * 128 + wr * 64 + m * 16 + fr, h = eg >> 9, e = eg & 511, et = e >> 5, el = e & 31;
                        const size_t base = ((((size_t)(gc * 4 + h) * 16 + et) * 8 + ks) * 64) * 8 + 4 * jhi;
                        const f32x4 v0 = acc[ai][bj][m][0] * r0, v1 = acc[ai][bj][m][1] * r1;
                        u32x2 w0, w1; w0.x = cvtpk(v0[0], v0[1]); w0.y = cvtpk(v0[2], v0[3]); w1.x = cvtpk(v1[0], v1[1]); w1.y = cvtpk(v1[2], v1[3]);
                        *(u32x2*)(VT + base + (size_t)(el) * 8) = w0;
                        *(u32x2*)(VT + base + (size_t)(32 + el) * 8) = w1;
                        asm volatile("" ::: "memory");
                    }
            }
        }
    }
};

struct EpiU {
    static constexpr bool MID = false;
    bf16_t* U; const float* rstd;
    __device__ __forceinline__ void mid(f32x4 (&)[2][2][4][2], const pg8::Unit&, int, int, int, int) const {}
    __device__ __forceinline__ void operator()(const f32x4 (&acc)[2][2][4][2], const pg8::Unit& u, int wr, int wc, int fr, int fq) const {
        const int col0 = u.pn * 128 + wc * 32 + 8 * fq;
#pragma unroll
        for (int ai = 0; ai < 2; ++ai)
#pragma unroll
            for (int m = 0; m < 4; ++m) {
                const int row = u.pm * 256 + ai * 128 + wr * 64 + m * 16 + fr; const float rs = rstd[row], r2 = rs * rs;
                const f32x4 v0 = acc[ai][0][m][0] * acc[ai][1][m][0] * r2, v1 = acc[ai][0][m][1] * acc[ai][1][m][1] * r2;
                u32x4 w; w.x = cvtpk(v0[0], v0[1]); w.y = cvtpk(v0[2], v0[3]); w.z = cvtpk(v1[0], v1[1]); w.w = cvtpk(v1[2], v1[3]);
                *(u32x4*)(U + (size_t)row * D + col0) = w;
            }
    }
};

__device__ __forceinline__ size_t zb_off(int m, int col  ) { return (((size_t)((m >> 7) * 64 + (col >> 5)) * 4 + ((m >> 5) & 3)) * 1024) + (m & 31) * 32 + (col & 31); }
__device__ __forceinline__ void unpack8(const u32x4 w, float (&f)[8]) { f[0] = bflo(w.x); f[1] = bfhi(w.x); f[2] = bflo(w.y); f[3] = bfhi(w.y); f[4] = bflo(w.z); f[5] = bfhi(w.z); f[6] = bflo(w.w); f[7] = bfhi(w.w); }

struct EpiB {
    static constexpr bool MID = false;
    const bf16_t* U; bf16_t* A1; bf16_t* ZB; bf16_t* SG; const float* rstd; const float* wconv;
    __device__ __forceinline__ void mid(f32x4 (&)[2][2][4][2], const pg8::Unit&, int, int, int, int) const {}
    __device__ __forceinline__ void operator()(const f32x4 (&acc)[2][2][4][2], const pg8::Unit& u, int wr, int wc, int fr, int fq) const {
        const int cl = wc * 32 + 8 * fq;
        if (u.pn < 4) {
#pragma unroll
            for (int bj = 0; bj < 2; ++bj) {
                const int ch0 = u.pn * 256 + bj * 128 + cl;
                float w0[8], w1[8], w2[8];
#pragma unroll
                for (int i = 0; i < 8; ++i) { w0[i] = wconv[ch0 + i]; w1[i] = wconv[D + ch0 + i]; w2[i] = wconv[2 * D + ch0 + i]; }
#pragma unroll
                for (int ai = 0; ai < 2; ++ai)
#pragma unroll
                    for (int m = 0; m < 4; ++m) {
                        const int row = u.pm * 256 + ai * 128 + wr * 64 + m * 16 + fr, pos = row & (SEQ - 1); const float rs = rstd[row];
                        const u32x4 uc = *(const u32x4*)(U + (size_t)row * D + ch0);
                        u32x4 up = (u32x4){0u, 0u, 0u, 0u}, un = (u32x4){0u, 0u, 0u, 0u};
                        if (pos > 0) up = *(const u32x4*)(U + (size_t)(row - 1) * D + ch0);
                        if (pos < SEQ - 1) un = *(const u32x4*)(U + (size_t)(row + 1) * D + ch0);
                        float fc[8], fp[8], fn[8]; unpack8(uc, fc); unpack8(up, fp); unpack8(un, fn);
                        float o[8];
#pragma unroll
                        for (int i = 0; i < 8; ++i) { const float a = (i < 4) ? acc[ai][bj][m][0][i & 3] : acc[ai][bj][m][1][i & 3]; o[i] = (a * rs) * (fp[i] * w0[i] + fc[i] * w1[i] + fn[i] * w2[i]); }
                        u32x4 w; w.x = cvtpk(o[0], o[1]); w.y = cvtpk(o[2], o[3]); w.z = cvtpk(o[4], o[5]); w.w = cvtpk(o[6], o[7]);
                        *(u32x4*)(A1 + (size_t)row * D + ch0) = w;
                    }
            }
        } else if (u.pn < 12) {
#pragma unroll
            for (int ai = 0; ai < 2; ++ai)
#pragma unroll
                for (int m = 0; m < 4; ++m) {
                    const int row = u.pm * 256 + ai * 128 + wr * 64 + m * 16 + fr; const float rs = rstd[row];
#pragma unroll
                    for (int bj = 0; bj < 2; ++bj) {
                        const int col0 = (u.pn - 4) * 256 + bj * 128 + cl; bf16_t* zp = ZB + zb_off(row, col0);
                        const u32x4 z = *(const u32x4*)zp; float zf[8]; unpack8(z, zf); float o[8];
#pragma unroll
                        for (int i = 0; i < 8; ++i) { const float a = ((i < 4) ? acc[ai][bj][m][0][i & 3] : acc[ai][bj][m][1][i & 3]) * rs; o[i] = zf[i] * siluf_(a); }
                        u32x4 w; w.x = cvtpk(o[0], o[1]); w.y = cvtpk(o[2], o[3]); w.z = cvtpk(o[4], o[5]); w.w = cvtpk(o[6], o[7]);
                        *(u32x4*)zp = w;
                    }
                }
        } else {
#pragma unroll
            for (int ai = 0; ai < 2; ++ai)
#pragma unroll
                for (int m = 0; m < 4; ++m) {
                    const int row = u.pm * 256 + ai * 128 + wr * 64 + m * 16 + fr; const float rs = rstd[row];
#pragma unroll
                    for (int bj = 0; bj < 2; ++bj) {
                        const int col0 = (u.pn - 12) * 256 + bj * 128 + cl; float o[8];
#pragma unroll
                        for (int i = 0; i < 8; ++i) { const float a = ((i < 4) ? acc[ai][bj][m][0][i & 3] : acc[ai][bj][m][1][i & 3]) * rs; o[i] = sigmoidf_(a); }
                        u32x4 w; w.x = cvtpk(o[0], o[1]); w.y = cvtpk(o[2], o[3]); w.z = cvtpk(o[4], o[5]); w.w = cvtpk(o[6], o[7]);
                        *(u32x4*)(SG + (size_t)row * 2048 + col0) = w;
                    }
                }
        }
    }
};

struct EpiMerge {
    static constexpr bool MID = true;
    const bf16_t* SG; bf16_t* MG;
    __device__ __forceinline__ void mid(f32x4 (&acc)[2][2][4][2], const pg8::Unit& u, int wr, int wc, int fr, int fq) const {
#pragma unroll
        for (int ai = 0; ai < 2; ++ai)
#pragma unroll
            for (int m = 0; m < 4; ++m) {
                const int row = u.pm * 256 + ai * 128 + wr * 64 + m * 16 + fr;
#pragma unroll
                for (int bj = 0; bj < 2; ++bj) {
                    const int col0 = u.pn * 256 + bj * 128 + wc * 32 + 8 * fq;
                    const u32x4 sa = *(const u32x4*)(SG + (size_t)row * 2048 + col0), sr = *(const u32x4*)(SG + (size_t)row * 2048 + 1024 + col0);
                    float fa[8], fr_[8]; unpack8(sa, fa); unpack8(sr, fr_);
#pragma unroll
                    for (int i = 0; i < 4; ++i) { acc[ai][bj][m][0][i] *= fa[i] / fr_[i]; acc[ai][bj][m][1][i] *= fa[4 + i] / fr_[4 + i]; }
                }
            }
    }
    __device__ __forceinline__ void operator()(const f32x4 (&acc)[2][2][4][2], const pg8::Unit& u, int wr, int wc, int fr, int fq) const {
#pragma unroll
        for (int ai = 0; ai < 2; ++ai)
#pragma unroll
            for (int m = 0; m < 4; ++m) {
                const int row = u.pm * 256 + ai * 128 + wr * 64 + m * 16 + fr;
#pragma unroll
                for (int bj = 0; bj < 2; ++bj) {
                    const int col0 = u.pn * 256 + bj * 128 + wc * 32 + 8 * fq;
                    const u32x4 sr = *(const u32x4*)(SG + (size_t)row * 2048 + 1024 + col0); float f[8]; unpack8(sr, f);
                    const f32x4 v0 = acc[ai][bj][m][0], v1 = acc[ai][bj][m][1];
                    u32x4 w; w.x = cvtpk(v0[0] * f[0], v0[1] * f[1]); w.y = cvtpk(v0[2] * f[2], v0[3] * f[3]); w.z = cvtpk(v1[0] * f[4], v1[1] * f[5]); w.w = cvtpk(v1[2] * f[6], v1[3] * f[7]);
                    *(u32x4*)(MG + (size_t)row * D + col0) = w;
                }
            }
    }
};

template <bool WRITE_BF> struct EpiRes {
    static constexpr bool MID = false;
    const float* xin; float* xo; bf16_t* xb; float* SS;
    __device__ __forceinline__ void mid(f32x4 (&)[2][2][4][2], const pg8::Unit&, int, int, int, int) const {}
    __device__ __forceinline__ void operator()(const f32x4 (&acc)[2][2][4][2], const pg8::Unit& u, int wr, int wc, int fr, int fq) const {
#pragma unroll
        for (int ai = 0; ai < 2; ++ai)
#pragma unroll
            for (int m = 0; m < 4; ++m) {
                const int row = u.pm * 256 + ai * 128 + wr * 64 + m * 16 + fr; float ss = 0.f;
#pragma unroll
                for (int bj = 0; bj < 2; ++bj) {
                    const int col0 = u.pn * 256 + bj * 128 + wc * 32 + 8 * fq; const size_t off = (size_t)row * D + col0;
                    const f32x4 v0 = *(const f32x4*)(xin + off) + acc[ai][bj][m][0], v1 = *(const f32x4*)(xin + off + 4) + acc[ai][bj][m][1];
                    *(f32x4*)(xo + off) = v0; *(f32x4*)(xo + off + 4) = v1;
                    ss += (v0[0] * v0[0] + v0[1] * v0[1]) + (v0[2] * v0[2] + v0[3] * v0[3]) + (v1[0] * v1[0] + v1[1] * v1[1]) + (v1[2] * v1[2] + v1[3] * v1[3]);
                    if (WRITE_BF) { u32x4 w; w.x = cvtpk(v0[0], v0[1]); w.y = cvtpk(v0[2], v0[3]); w.z = cvtpk(v1[0], v1[1]); w.w = cvtpk(v1[2], v1[3]); *(u32x4*)(xb + off) = w; }
                }
                ss += __shfl_xor(ss, 16); ss += __shfl_xor(ss, 32);
                if (fq == 0) SS[(size_t)row * 16 + u.pn * 4 + wc] = ss;
            }
    }
};

struct EpiGU {
    static constexpr bool MID = false;
    bf16_t* ACT; const float* SS;
    __device__ __forceinline__ void mid(f32x4 (&)[2][2][4][2], const pg8::Unit&, int, int, int, int) const {}
    __device__ __forceinline__ void operator()(const f32x4 (&acc)[2][2][4][2], const pg8::Unit& u, int wr, int wc, int fr, int fq) const {
        const int col0 = u.pn * 128 + wc * 32 + 8 * fq;
#pragma unroll
        for (int ai = 0; ai < 2; ++ai)
#pragma unroll
            for (int m = 0; m < 4; ++m) {
                const int row = u.pm * 256 + ai * 128 + wr * 64 + m * 16 + fr;
                const f32x4 p0 = *(const f32x4*)(SS + (size_t)row * 16), p1 = *(const f32x4*)(SS + (size_t)row * 16 + 4), p2 = *(const f32x4*)(SS + (size_t)row * 16 + 8), p3 = *(const f32x4*)(SS + (size_t)row * 16 + 12);
                const f32x4 ps = (p0 + p1) + (p2 + p3); const float rs = 1.0f / sqrtf(((ps[0] + ps[1]) + (ps[2] + ps[3])) * (1.0f / D) + EPS);
                float o[8];
#pragma unroll
                for (int i = 0; i < 8; ++i) { const float gt = ((i < 4) ? acc[ai][0][m][0][i & 3] : acc[ai][0][m][1][i & 3]) * rs, up = ((i < 4) ? acc[ai][1][m][0][i & 3] : acc[ai][1][m][1][i & 3]) * rs; o[i] = siluf_(gt) * up; }
                u32x4 w; w.x = cvtpk(o[0], o[1]); w.y = cvtpk(o[2], o[3]); w.z = cvtpk(o[4], o[5]); w.w = cvtpk(o[6], o[7]);
                *(u32x4*)(ACT + (size_t)row * DFF + col0) = w;
            }
    }
};
#define XB_TMO      128
#define XB_XCNT(j)  (256  + 64 * (j))
#define XB_XSUB(j)  (1280 + 64 * (j))
#define XB_XGEN(j)  (2304 + 64 * (j))
#define XB_TOP      3328
#define XB_TOPGEN   3392
#define XCD_BAR_WORDS 3456
#define XB_SPIN_CAP (1u << 18)
__device__ __forceinline__ unsigned xb_ld(unsigned* p)              { return __hip_atomic_load(p, __ATOMIC_RELAXED, __HIP_MEMORY_SCOPE_AGENT); }
__device__ __forceinline__ unsigned xb_add(unsigned* p, unsigned v) { return __hip_atomic_fetch_add(p, v, __ATOMIC_RELAXED, __HIP_MEMORY_SCOPE_AGENT); }
__device__ __forceinline__ unsigned xb_xcc_id() { return (unsigned)__builtin_amdgcn_s_getreg((3 << 11) | 20) & 0xFu; }
#define XB_SPIN(cond, bar) do { unsigned _sp = 0; while (cond) { __builtin_amdgcn_s_sleep(1); \
    if ((++_sp & 255u) == 0u) { if (xb_ld(&(bar)[XB_TMO])) break; if (_sp > XB_SPIN_CAP) { atomicAdd(&(bar)[XB_TMO], 1u); break; } } } } while (0)
struct XcdBarrier { unsigned* bar; unsigned x; volatile LAS unsigned* st; int wave_s; };
__device__ __forceinline__ XcdBarrier xcd_barrier_post(unsigned* bar, volatile LAS unsigned* st, int wave_s) {
    XcdBarrier b; b.bar = bar; b.x = xb_xcc_id(); b.st = st; b.wave_s = wave_s;
    if (wave_s == 0 && lane_id() == 0) (void)xb_add(&bar[XB_XCNT(b.x)], 1u);
    return b;
}
__device__ __forceinline__ void xcd_barrier_complete(unsigned* bar, unsigned x, unsigned& nloc, unsigned& nx) {
    const unsigned G = gridDim.x * gridDim.y * gridDim.z;
    unsigned sum, cnt, mine, sp = 0u;
    for (;;) {
        sum = 0u; cnt = 0u; mine = 0u;
#pragma unroll
        for (unsigned j = 0; j < 16; ++j) { const unsigned c = xb_ld(&bar[XB_XCNT(j)]); sum += c; cnt += (c > 0u) ? 1u : 0u; mine = (j == x) ? c : mine; }
        if (sum == G) break;
        __builtin_amdgcn_s_sleep(1);
        if ((++sp & 255u) == 0u) { if (xb_ld(&bar[XB_TMO])) break; if (sp > XB_SPIN_CAP) { atomicAdd(&bar[XB_TMO], 1u); break; } }
    }
    nloc = mine > 0u ? mine : 1u; nx = cnt > 0u ? cnt : 1u;
}
__device__ __forceinline__ void xcd_barrier(const XcdBarrier& b) {
    asm volatile("s_waitcnt vmcnt(0)" ::: "memory");
    __syncthreads();
    if (b.wave_s == 0 && lane_id() == 0) {
        unsigned* bar = b.bar;
        __builtin_amdgcn_s_waitcnt(0);
        unsigned nloc = b.st[0], nx = b.st[1];
        if (nloc == 0u) { xcd_barrier_complete(bar, b.x, nloc, nx); b.st[0] = nloc; b.st[1] = nx; }
        const unsigned old = xb_add(&bar[XB_XSUB(b.x)], 1u);
        const unsigned gen = old / nloc;
        if (old + 1u == (gen + 1u) * nloc) {
            __builtin_amdgcn_fence(__ATOMIC_RELEASE, "agent");
            asm volatile("s_waitcnt vmcnt(0)" ::: "memory");
            const unsigned og = xb_add(&bar[XB_TOP], 1u);
            const unsigned tg = og / nx;
            if (og + 1u == (tg + 1u) * nx) xb_add(&bar[XB_TOPGEN], 1u);
            else XB_SPIN(xb_ld(&bar[XB_TOPGEN]) == tg, bar);
            __builtin_amdgcn_fence(__ATOMIC_ACQUIRE, "agent");
            xb_add(&bar[XB_XGEN(b.x)], 1u);
            asm volatile("s_waitcnt vmcnt(0)" ::: "memory");
        } else {
            XB_SPIN(xb_ld(&bar[XB_XGEN(b.x)]) == gen, bar);
            __builtin_amdgcn_fence(__ATOMIC_ACQUIRE, "agent");
            asm volatile("s_waitcnt vmcnt(0)" ::: "memory");
        }
    }
    __syncthreads();
}

constexpr size_t MiB = 1u << 20;
constexpr size_t WS_CTL = 0, CTL_ZERO_BYTES = 64 * 1024;
constexpr size_t WS_WIN = 1 * MiB;
constexpr size_t WS_WAR = 23 * MiB;
constexpr size_t WS_WO = 29 * MiB;
constexpr size_t WS_WGU = 31 * MiB;
constexpr size_t WS_WD = 42 * MiB;
constexpr size_t WS_RSTD = 48 * MiB;
constexpr size_t WS_SS1 = 49 * MiB;
constexpr size_t WS_SS2 = 50 * MiB;
constexpr size_t WS_XB = 51 * MiB;
constexpr size_t WS_QF = 83 * MiB;
constexpr size_t WS_KF = 115 * MiB;
constexpr size_t WS_KT = 147 * MiB;
constexpr size_t WS_ROPE = 179 * MiB;
constexpr size_t WS_R = 179 * MiB;
constexpr size_t WS_MG = WS_QF, WS_A1 = WS_KF, WS_X1B = WS_KF, WS_U = WS_KT, WS_ACT = WS_KT;
constexpr size_t WS_END = 256 * MiB;
static_assert(WS_R + 64 * MiB <= WS_END && WS_ACT + (size_t)M * DFF * 2 <= WS_END, "ws map");
constexpr int CW_BAR = 1024;

constexpr int LDS_MISC = 131072, LDS_BYTES = 147456;

struct Params {
    const float* x; const float* g_mix; const float* w_in; const float* w_conv; const float* dec_f; const float* dec_b; const float* g_ret;
    const float* w_a_out; const float* w_r_out; const float* w_o; const float* g_ffn; const float* w_ff_gate; const float* w_ff_up; const float* w_ff_down; const float* g_final;
    float* out; unsigned char* ws;
};

__device__ __forceinline__ void p0_tr_item(const float* W, int Nsrc, int k0, int n0s, bf16_t* dst, int ldd, int n0d, int koff, const float* gk, LAS float* scr, int lane) {
#pragma unroll 8
    for (int i = 0; i < 32; ++i) { const int kk = 2 * i + (lane >> 5); const float g = gk ? gk[k0 + kk] : 1.0f; scr[kk * 33 + (lane & 31)] = W[(size_t)(k0 + kk) * Nsrc + n0s + (lane & 31)] * g; }
    LDS_WAIT(); asm volatile("" ::: "memory");
    const int c = lane & 7;
#pragma unroll
    for (int j = 0; j < 4; ++j) { const int n = (lane >> 3) + 8 * j; const LAS float* s = scr + (8 * c) * 33 + n;
        u32x4 o; o.x = cvtpk(s[0 * 33], s[1 * 33]); o.y = cvtpk(s[2 * 33], s[3 * 33]); o.z = cvtpk(s[4 * 33], s[5 * 33]); o.w = cvtpk(s[6 * 33], s[7 * 33]);
        *(u32x4*)(dst + (size_t)(n0d + n) * ldd + koff + k0 + 8 * c) = o; }
    LDS_WAIT(); asm volatile("" ::: "memory");
}
__device__ __forceinline__ int win_src_col(int n0d) {
    if (n0d < 1024) return 3072 + n0d;
    if (n0d < 2048) return 4096 + (n0d - 1024);
    if (n0d < 4096) return 5120 + (n0d - 2048);
    if (n0d < 6144) { const int o = n0d - 4096, t = o >> 8, i = o & 255; return (i < 128) ? 128 * t + i : 2048 + 128 * t + (i - 128); }
    if (n0d < 7168) return 1024 + (n0d - 6144);
    return n0d;
}
__device__ __forceinline__ void sincos_d(float angf, float& sn, float& cs) {
    const double a = (double)angf; const double kq = __builtin_rint(a * 0.63661977236758134308);
    double r = __builtin_fma(-kq, 1.57079632679489655800, a); r = __builtin_fma(-kq, 6.12323399573676603587e-17, r);
    const double r2 = r * r;
    double s = -1.0 / 1307674368000.0; s = s * r2 + 1.0 / 6227020800.0; s = s * r2 - 1.0 / 39916800.0; s = s * r2 + 1.0 / 362880.0; s = s * r2 - 1.0 / 5040.0; s = s * r2 + 1.0 / 120.0; s = s * r2 - 1.0 / 6.0; s = s * r2 * r + r;
    double c = 1.0 / 20922789888000.0; c = c * r2 - 1.0 / 87178291200.0; c = c * r2 + 1.0 / 479001600.0; c = c * r2 - 1.0 / 3628800.0; c = c * r2 + 1.0 / 40320.0; c = c * r2 - 1.0 / 720.0; c = c * r2 + 1.0 / 24.0; c = c * r2 - 0.5; c = c * r2 + 1.0;
    const int q = (int)((long long)kq & 3);
    const double ss = (q == 0) ? s : (q == 1) ? c : (q == 2) ? -s : -c, cc = (q == 0) ? c : (q == 1) ? -s : (q == 2) ? -c : s;
    sn = (float)ss; cs = (float)cc;
}
__device__ __forceinline__ float rope_freq(int j) { return (float)exp2(-(double)j * (13.287712379549449 / 128.0)); }

__device__ __forceinline__ void p0_prologue(const Params& p, LAS unsigned char* lds, int vcu, int G, int wave_s) {
    const int tid_o = opaque_tid(wave_s), lane = tid_o & 63, wave = wave_s;
    LAS float* scr = (LAS float*)(lds + wave * 16384);
    const int gw = vcu * NWAVES + wave, NGW = G * NWAVES;
    bf16_t* WIN = (bf16_t*)(p.ws + WS_WIN); bf16_t* WAR = (bf16_t*)(p.ws + WS_WAR); bf16_t* WO = (bf16_t*)(p.ws + WS_WO); bf16_t* WGU = (bf16_t*)(p.ws + WS_WGU); bf16_t* WD = (bf16_t*)(p.ws + WS_WD);
    constexpr int I_IN = 16 * (NIN / 32), I_A = 16 * 32, I_R = 32 * 32, I_O = 16 * 32, I_GU = 16 * (2 * DFF / 32), I_D = (DFF / 64) * 32;
    constexpr int NITEMS = I_IN + I_A + I_R + I_O + I_GU + I_D;
    for (int it = gw; it < NITEMS; it += NGW) {
        int r = it;
        if (r < I_IN) { const int nb = r % (NIN / 32), kb = r / (NIN / 32); p0_tr_item(p.w_in, NIN, 64 * kb, win_src_col(32 * nb), WIN, D, 32 * nb, 0, p.g_mix, scr, lane); continue; } r -= I_IN;
        if (r < I_A) { const int nb = r % 32, kb = r / 32; p0_tr_item(p.w_a_out, D, 64 * kb, 32 * nb, WAR, 3072, 32 * nb, 0, nullptr, scr, lane); continue; } r -= I_A;
        if (r < I_R) { const int nb = r % 32, kb = r / 32; p0_tr_item(p.w_r_out, D, 64 * kb, 32 * nb, WAR, 3072, 32 * nb, 1024, nullptr, scr, lane); continue; } r -= I_R;
        if (r < I_O) { const int nb = r % 32, kb = r / 32; p0_tr_item(p.w_o, D, 64 * kb, 32 * nb, WO, D, 32 * nb, 0, nullptr, scr, lane); continue; } r -= I_O;
        if (r < I_GU) { const int nb = r % (2 * DFF / 32), kb = r / (2 * DFF / 32); const int n0d = 32 * nb, t = n0d >> 8, i = n0d & 255;
            if (i < 128) p0_tr_item(p.w_ff_gate, DFF, 64 * kb, 128 * t + i, WGU, D, n0d, 0, p.g_ffn, scr, lane);
            else p0_tr_item(p.w_ff_up, DFF, 64 * kb, 128 * t + (i - 128), WGU, D, n0d, 0, p.g_ffn, scr, lane);
            continue; } r -= I_GU;
        { const int nb = r % 32, kb = r / 32; p0_tr_item(p.w_ff_down, D, 64 * kb, 32 * nb, WD, DFF, 32 * nb, 0, nullptr, scr, lane); }
    }
    bf16_t* XB = (bf16_t*)(p.ws + WS_XB); float* RSTD = (float*)(p.ws + WS_RSTD);
    for (int m = gw; m < M; m += NGW) {
        const f32x4* xr = (const f32x4*)(p.x + (size_t)m * D) + lane; f32x4 v[4]; float s = 0.f;
#pragma unroll
        for (int j = 0; j < 4; ++j) { v[j] = xr[64 * j]; s += (v[j].x * v[j].x + v[j].y * v[j].y) + (v[j].z * v[j].z + v[j].w * v[j].w); }
        s = wave_sum(s);
        if (lane == 0) RSTD[m] = 1.0f / sqrtf(s * (1.0f / D) + EPS);
        u32x2* o8 = (u32x2*)(XB + (size_t)m * D) + lane;
#pragma unroll
        for (int j = 0; j < 4; ++j) { u32x2 w; w.x = cvtpk(v[j].x, v[j].y); w.y = cvtpk(v[j].z, v[j].w); o8[64 * j] = w; }
    }
    float* CS = (float*)(p.ws + WS_ROPE); float* SN = CS + (size_t)SEQ * 128; float* CST = SN + (size_t)SEQ * 128; float* SNT = CST + (size_t)SEQ * 128;
    const int gt = gw * 64 + lane, NGT = NGW * 64;
    for (int i = gt; i < SEQ * 128; i += NGT) { const int pos = i >> 7, j = i & 127; float sn, cs; sincos_d((float)pos * rope_freq(j), sn, cs); CS[i] = cs; SN[i] = sn; }
    for (int i = gt; i < SEQ * 128; i += NGT) { const int j = i >> 13, pos = i & (SEQ - 1); float sn, cs; sincos_d((float)pos * rope_freq(j), sn, cs); CST[i] = cs; SNT[i] = sn; }
}

constexpr int SC_VS = 0, SC_XI = 16384, SC_XI_PITCH = 528, SC_XI_BYTES = 32 * SC_XI_PITCH;
typedef u32x4 qset_t[16];
typedef u32x4 kset_t[2][8];

__device__ __forceinline__ void scan_vscale_store(LAS unsigned char* lds, int buf, int ks, int lane, const u32x4 v, const float (&z)[8]) {
    float f[8]; unpack8(v, f); u32x4 w;
    w.x = cvtpk(f[0] * z[0], f[1] * z[1]); w.y = cvtpk(f[2] * z[2], f[3] * z[3]); w.z = cvtpk(f[4] * z[4], f[5] * z[5]); w.w = cvtpk(f[6] * z[6], f[7] * z[7]);
    *(LAS u32x4*)(lds + SC_VS + buf * 8192 + ks * 1024 + lane * 16) = w;
}

struct ScanCtx {
    const bf16_t* QF; const bf16_t* KT; const bf16_t* VT; unsigned* R;
    int b, h, dir, es, lane;
    float lg;
};
__device__ __forceinline__ int scan_gc(const ScanCtx& c, int i) { return c.b * NCH + (c.dir ? (NCH - 1 - i) : i); }

template <int P, bool SECOND>
__device__ __forceinline__ void cross_step(const ScanCtx& c, LAS unsigned char* lds, int w, int i, const qset_t& qc, qset_t& qn, u32x4 (&vt)[2], const float (&zeta)[2][8], float xi_s) {
    const int lane = c.lane, r = lane & 31, hh = lane >> 5;
    const int gcc = scan_gc(c, i), gcn = scan_gc(c, (i + 1 < NCH) ? i + 1 : i), gcv = scan_gc(c, (i + 3 < NCH) ? i + 3 : NCH - 1);
    { const u32x4* src = (const u32x4*)(c.QF + ((((size_t)(gcn * 4 + c.h) * 4 + w) * 16) * 64) * 8) + lane;
#pragma unroll
      for (int kd = 0; kd < 16; ++kd) qn[kd] = src[kd * 64]; }
    unsigned* rp = c.R + ((((size_t)(gcc * 4 + c.h) * 16 + c.es) * 4 + w) * 2) * 256 + lane * 4;
    u32x4 pb0 = (u32x4){0u, 0u, 0u, 0u}, pb1 = (u32x4){0u, 0u, 0u, 0u};
    if (SECOND) { pb0 = *(const u32x4*)rp; pb1 = *(const u32x4*)(rp + 256); }
    f32x16 o;
#pragma unroll
    for (int k = 0; k < 16; ++k) o[k] = 0.f;
    const LAS unsigned char* xi = lds + SC_XI + P * SC_XI_BYTES + r * SC_XI_PITCH + hh * 16;
#pragma unroll
    for (int kd = 0; kd < 16; ++kd) {
        const bf16x8 a = *(const LAS bf16x8*)(xi + kd * 32);
        o = __builtin_amdgcn_mfma_f32_32x32x16_bf16(a, __builtin_bit_cast(bf16x8, qc[kd]), o, 0, 0, 0);
    }
#pragma unroll
    for (int k = 0; k < 16; ++k) o[k] *= xi_s;
    if (SECOND) {
        const unsigned pw[8] = {pb0.x, pb0.y, pb0.z, pb0.w, pb1.x, pb1.y, pb1.z, pb1.w};
#pragma unroll
        for (int k = 0; k < 8; ++k) { o[2 * k] += bflo(pw[k]); o[2 * k + 1] += bfhi(pw[k]); }
    }
    u32x4 w0, w1;
    w0.x = cvtpk(o[0], o[1]); w0.y = cvtpk(o[2], o[3]); w0.z = cvtpk(o[4], o[5]); w0.w = cvtpk(o[6], o[7]);
    w1.x = cvtpk(o[8], o[9]); w1.y = cvtpk(o[10], o[11]); w1.z = cvtpk(o[12], o[13]); w1.w = cvtpk(o[14], o[15]);
    *(u32x4*)rp = w0; *(u32x4*)(rp + 256) = w1;
    scan_vscale_store(lds, P ^ 1, 2 * w, lane, vt[0], zeta[0]);
    scan_vscale_store(lds, P ^ 1, 2 * w + 1, lane, vt[1], zeta[1]);
    { const u32x4* src = (const u32x4*)(c.VT + ((((size_t)(gcv * 4 + c.h) * 16 + c.es) * 8 + 2 * w) * 64) * 8) + lane; vt[0] = src[0]; vt[1] = src[64]; }
    __syncthreads();
}
template <bool SECOND>
__device__ __forceinline__ void cross_half(const ScanCtx& c, LAS unsigned char* lds, int w, int i0, qset_t& qa, qset_t& qb, u32x4 (&vt0)[2], u32x4 (&vt1)[2], const float (&zeta)[2][8], float xi_s) {
    for (int i = i0; i < i0 + NCH / 2; i += 2) {
        cross_step<0, SECOND>(c, lds, w, i, qa, qb, vt1, zeta, xi_s);
        cross_step<1, SECOND>(c, lds, w, i + 1, qb, qa, vt0, zeta, xi_s);
    }
}
__device__ __forceinline__ void cross_role(const ScanCtx& c, LAS unsigned char* lds, const XcdBarrier& bar, int w) {
    const int lane = c.lane, r = lane & 31, hh = lane >> 5;
    const int t = 32 * w + r; const float xi_s = exp2f((c.dir ? (float)(128 - t) : (float)(t + 1)) * c.lg);
    float zeta[2][8];
#pragma unroll
    for (int f = 0; f < 2; ++f)
#pragma unroll
        for (int j = 0; j < 8; ++j) { const int s = 16 * (2 * w + f) + 8 * (j >> 2) + 4 * hh + (j & 3); zeta[f][j] = exp2f((c.dir ? (float)s : (float)(127 - s)) * c.lg); }
    qset_t qa, qb; u32x4 vt0[2], vt1[2];
    const int g0 = scan_gc(c, 0), g1 = scan_gc(c, 1), g2 = scan_gc(c, 2);
    { const u32x4* src = (const u32x4*)(c.QF + ((((size_t)(g0 * 4 + c.h) * 4 + w) * 16) * 64) * 8) + lane;
#pragma unroll
      for (int kd = 0; kd < 16; ++kd) { qa[kd] = src[kd * 64]; qb[kd] = (u32x4){0u, 0u, 0u, 0u}; } }
    { const u32x4* src = (const u32x4*)(c.VT + ((((size_t)(g0 * 4 + c.h) * 16 + c.es) * 8 + 2 * w) * 64) * 8) + lane;
      scan_vscale_store(lds, 0, 2 * w, lane, src[0], zeta[0]); scan_vscale_store(lds, 0, 2 * w + 1, lane, src[64], zeta[1]); }
    { const u32x4* src = (const u32x4*)(c.VT + ((((size_t)(g1 * 4 + c.h) * 16 + c.es) * 8 + 2 * w) * 64) * 8) + lane; vt1[0] = src[0]; vt1[1] = src[64]; }
    { const u32x4* src = (const u32x4*)(c.VT + ((((size_t)(g2 * 4 + c.h) * 16 + c.es) * 8 + 2 * w) * 64) * 8) + lane; vt0[0] = src[0]; vt0[1] = src[64]; }
    __syncthreads();
    cross_half<false>(c, lds, w, 0, qa, qb, vt0, vt1, zeta, xi_s);
    xcd_barrier(bar);
    cross_half<true>(c, lds, w, NCH / 2, qa, qb, vt0, vt1, zeta, xi_s);
}

template <int P>
__device__ __forceinline__ void update_step(const ScanCtx& c, LAS unsigned char* lds, int w, int i, const kset_t& kc, kset_t& kn, f32x16 (&X)[2], float decay) {
    const int lane = c.lane, r = lane & 31, hh = lane >> 5;
    const int gcn = scan_gc(c, (i + 1 < NCH) ? i + 1 : i);
#pragma unroll
    for (int tI = 0; tI < 2; ++tI) { const u32x4* src = (const u32x4*)(c.KT + ((((size_t)(gcn * 4 + c.h) * 8 + 2 * w + tI) * 8) * 64) * 8) + lane;
#pragma unroll
        for (int ks = 0; ks < 8; ++ks) kn[tI][ks] = src[ks * 64]; }
#pragma unroll
    for (int k = 0; k < 16; ++k) { X[0][k] *= decay; X[1][k] *= decay; }
    const LAS unsigned char* vs = lds + SC_VS + P * 8192 + lane * 16;
#pragma unroll
    for (int ks = 0; ks < 8; ++ks) {
        const bf16x8 bv = *(const LAS bf16x8*)(vs + ks * 1024);
        X[0] = __builtin_amdgcn_mfma_f32_32x32x16_bf16(__builtin_bit_cast(bf16x8, kc[0][ks]), bv, X[0], 0, 0, 0);
        X[1] = __builtin_amdgcn_mfma_f32_32x32x16_bf16(__builtin_bit_cast(bf16x8, kc[1][ks]), bv, X[1], 0, 0, 0);
    }
    LAS unsigned char* xo = lds + SC_XI + (P ^ 1) * SC_XI_BYTES + r * SC_XI_PITCH;
#pragma unroll
    for (int tI = 0; tI < 2; ++tI)
#pragma unroll
        for (int g = 0; g < 4; ++g) { u32x2 pk; pk.x = cvtpk(X[tI][4 * g], X[tI][4 * g + 1]); pk.y = cvtpk(X[tI][4 * g + 2], X[tI][4 * g + 3]);
            *(LAS u32x2*)(xo + (32 * (2 * w + tI) + 8 * g + 4 * hh) * 2) = pk; }
    __syncthreads();
}
__device__ __forceinline__ void update_half(const ScanCtx& c, LAS unsigned char* lds, int w, int i0, kset_t& ka, kset_t& kb, f32x16 (&X)[2], float decay) {
    for (int i = i0; i < i0 + NCH / 2; i += 2) {
        update_step<0>(c, lds, w, i, ka, kb, X, decay);
        update_step<1>(c, lds, w, i + 1, kb, ka, X, decay);
    }
}
__device__ __forceinline__ void update_role(const ScanCtx& c, LAS unsigned char* lds, const XcdBarrier& bar, int w) {
    const int lane = c.lane; const float decay = exp2f(128.0f * c.lg);
    kset_t ka, kb; f32x16 X[2];
#pragma unroll
    for (int k = 0; k < 16; ++k) { X[0][k] = 0.f; X[1][k] = 0.f; }
    const int g0 = scan_gc(c, 0);
#pragma unroll
    for (int tI = 0; tI < 2; ++tI) { const u32x4* src = (const u32x4*)(c.KT + ((((size_t)(g0 * 4 + c.h) * 8 + 2 * w + tI) * 8) * 64) * 8) + lane;
#pragma unroll
        for (int ks = 0; ks < 8; ++ks) { ka[tI][ks] = src[ks * 64]; kb[tI][ks] = (u32x4){0u, 0u, 0u, 0u}; } }
    __syncthreads();
    update_half(c, lds, w, 0, ka, kb, X, decay);
    xcd_barrier(bar);
    update_half(c, lds, w, NCH / 2, ka, kb, X, decay);
}
__device__ __forceinline__ float log2_gamma(float logit) { return -log1pf(__expf(-logit)) * 1.44269504088896340736f; }

__device__ __forceinline__ void scan_phase(const Params& p, LAS unsigned char* lds, const XcdBarrier& bar, int wave_s) {
    const int tid_o = opaque_tid(wave_s), lane = tid_o & 63, wid = wave_s;
    const int item = blockIdx.x, bh = item & 7, sub = item >> 3;
    ScanCtx c; c.QF = (const bf16_t*)(p.ws + WS_QF); c.KT = (const bf16_t*)(p.ws + WS_KT); c.VT = (const bf16_t*)p.out; c.R = (unsigned*)(p.ws + WS_R);
    c.b = bh >> 2; c.h = bh & 3; c.dir = sub & 1; c.es = sub >> 1; c.lane = lane;
    c.lg = log2_gamma(c.dir ? p.dec_b[c.h] : p.dec_f[c.h]);
    for (int o = tid_o * 16; o < SC_XI_BYTES; o += NTHREADS * 16) *(LAS u32x4*)(lds + SC_XI + o) = (u32x4){0u, 0u, 0u, 0u};
    if (wid < 4) cross_role(c, lds, bar, wid); else update_role(c, lds, bar, wid - 4);
}

constexpr int P3_STAT = 65536;
__device__ __forceinline__ void intra_phase(const Params& p, LAS unsigned char* lds, int wave_s) {
    const int tid_o = opaque_tid(wave_s), lane = tid_o & 63, wid = wave_s;
    const bf16_t* QF = (const bf16_t*)(p.ws + WS_QF); const bf16_t* KF = (const bf16_t*)(p.ws + WS_KF); const bf16_t* VT = (const bf16_t*)p.out;
    unsigned* R = (unsigned*)(p.ws + WS_R);
    const int tt = wid & 3, eh = wid >> 2;
    LAS float* stat = (LAS float*)(lds + P3_STAT);
    for (int item = blockIdx.x; item < NGC * NH; item += gridDim.x) {
        const int gc = item >> 2, h = item & 3;
        int lane_o = lane; asm volatile("" : "+v"(lane_o));
        const int lane = lane_o, r = lane & 31, hh = lane >> 5;
        const float lgf = log2_gamma(p.dec_f[h]), lgb = log2_gamma(p.dec_b[h]);
        u32x4 qf[16];
        { const u32x4* src = (const u32x4*)(QF + ((((size_t)(gc * 4 + h) * 4 + tt) * 16) * 64) * 8) + lane;
#pragma unroll
          for (int kd = 0; kd < 16; ++kd) qf[kd] = src[kd * 64]; }
        LAS unsigned char* xbl = lds + wid * 8192;
#pragma unroll
        for (int st = 0; st < 4; ++st) {
            f32x16 sacc;
#pragma unroll
            for (int k = 0; k < 16; ++k) sacc[k] = 0.f;
            const u32x4* ksrc = (const u32x4*)(KF + ((((size_t)(gc * 4 + h) * 4 + st) * 16) * 64) * 8) + lane;
#pragma unroll
            for (int kd = 0; kd < 16; ++kd) { const u32x4 kf = ksrc[kd * 64];
                sacc = __builtin_amdgcn_mfma_f32_32x32x16_bf16(__builtin_bit_cast(bf16x8, kf), __builtin_bit_cast(bf16x8, qf[kd]), sacc, 0, 0, 0);
                if ((kd & 3) == 3) asm volatile("" ::: "memory"); }
            const int t = 32 * tt + r;
#pragma unroll
            for (int k = 0; k < 16; ++k) { const int s = 32 * st + (k & 3) + 8 * (k >> 2) + 4 * hh; const int df = t - s;
                const float dec = (df >= 0) ? exp2f((float)df * lgf) : exp2f((float)(-df) * lgb); sacc[k] *= dec; }
            u32x4 x0, x1;
            x0.x = cvtpk(sacc[0], sacc[1]); x0.y = cvtpk(sacc[2], sacc[3]); x0.z = cvtpk(sacc[4], sacc[5]); x0.w = cvtpk(sacc[6], sacc[7]);
            x1.x = cvtpk(sacc[8], sacc[9]); x1.y = cvtpk(sacc[10], sacc[11]); x1.z = cvtpk(sacc[12], sacc[13]); x1.w = cvtpk(sacc[14], sacc[15]);
            *(LAS u32x4*)(xbl + (st * 2) * 1024 + lane * 16) = x0; *(LAS u32x4*)(xbl + (st * 2 + 1) * 1024 + lane * 16) = x1;
            asm volatile("" ::: "memory");
        }
        f32x16 o[8];
#pragma unroll
        for (int et8 = 0; et8 < 8; ++et8) {
            const int et = eh * 8 + et8;
#pragma unroll
            for (int k = 0; k < 16; ++k) o[et8][k] = 0.f;
            const u32x4* vsrc = (const u32x4*)(VT + ((((size_t)(gc * 4 + h) * 16 + et) * 8) * 64) * 8) + lane;
#pragma unroll
            for (int ks = 0; ks < 8; ++ks) { const u32x4 vf = vsrc[ks * 64];
                const bf16x8 xf = *(const LAS bf16x8*)(xbl + ks * 1024 + lane * 16);
                o[et8] = __builtin_amdgcn_mfma_f32_32x32x16_bf16(__builtin_bit_cast(bf16x8, vf), xf, o[et8], 0, 0, 0);
                if (ks == 3) asm volatile("" ::: "memory"); }
            const unsigned* rp = R + ((((size_t)(gc * 4 + h) * 16 + et) * 4 + tt) * 2) * 256 + lane * 4;
            const u32x4 b0 = *(const u32x4*)rp, b1 = *(const u32x4*)(rp + 256);
            const unsigned pw[8] = {b0.x, b0.y, b0.z, b0.w, b1.x, b1.y, b1.z, b1.w};
#pragma unroll
            for (int k = 0; k < 8; ++k) { o[et8][2 * k] += bflo(pw[k]); o[et8][2 * k + 1] += bfhi(pw[k]); }
            asm volatile("" ::: "memory"); __builtin_amdgcn_sched_barrier(0);
        }
        float s1 = 0.f;
#pragma unroll
        for (int et8 = 0; et8 < 8; ++et8)
#pragma unroll
            for (int k = 0; k < 16; ++k) s1 += o[et8][k];
        s1 += __shfl_xor(s1, 32);
        if (hh == 0) stat[eh * 128 + 32 * tt + r] = s1;
        __syncthreads();
        const float mean = (stat[32 * tt + r] + stat[128 + 32 * tt + r]) * (1.0f / DV);
        float s2 = 0.f;
#pragma unroll
        for (int et8 = 0; et8 < 8; ++et8)
#pragma unroll
            for (int k = 0; k < 16; ++k) { const float d = o[et8][k] - mean; s2 += d * d; }
        s2 += __shfl_xor(s2, 32);
        if (hh == 0) stat[256 + eh * 128 + 32 * tt + r] = s2;
        __syncthreads();
        const float rstd = 1.0f / sqrtf((stat[256 + 32 * tt + r] + stat[256 + 128 + 32 * tt + r]) * (1.0f / DV) + EPS);
        bf16_t* ZB = (bf16_t*)R;
        int lane_s = lane; asm volatile("" : "+v"(lane_s)); const int r_s = lane_s & 31, hh_s = lane_s >> 5;
#pragma unroll
        for (int et8 = 0; et8 < 8; ++et8) {
            const int et = eh * 8 + et8;
            bf16_t* zt = ZB + (((size_t)(gc * 64 + h * 16 + et) * 4 + tt) * 1024) + r_s * 32;
#pragma unroll
            for (int g = 0; g < 4; ++g) {
                const f32x4 gr = *(const f32x4*)(p.g_ret + h * DV + 32 * et + 8 * g + 4 * hh_s);
                u32x2 pk; pk.x = cvtpk((o[et8][4 * g] - mean) * rstd * gr[0], (o[et8][4 * g + 1] - mean) * rstd * gr[1]);
                pk.y = cvtpk((o[et8][4 * g + 2] - mean) * rstd * gr[2], (o[et8][4 * g + 3] - mean) * rstd * gr[3]);
                *(u32x2*)(zt + 8 * g + 4 * hh_s) = pk;
            }
            asm volatile("" ::: "memory"); __builtin_amdgcn_sched_barrier(0);
        }
        __syncthreads();
    }
}

__device__ __forceinline__ void final_phase(const Params& p, int vcu, int G, int wave_s) {
    const int tid_o = opaque_tid(wave_s), lane = tid_o & 63, wave = wave_s;
    const float* SS2 = (const float*)(p.ws + WS_SS2);
    const int gw = vcu * NWAVES + wave, NGW = G * NWAVES;
    for (int m = gw; m < M; m += NGW) {
        float ss = (lane < 16) ? SS2[(size_t)m * 16 + lane] : 0.f; ss = wave_sum(ss);
        const float rs = 1.0f / sqrtf(ss * (1.0f / D) + EPS);
        f32x4* xr = (f32x4*)(p.out + (size_t)m * D) + lane; const f32x4* gr = (const f32x4*)p.g_final + lane;
#pragma unroll
        for (int j = 0; j < 4; ++j) { const f32x4 v = xr[64 * j], g = gr[64 * j]; xr[64 * j] = v * rs * g; }
    }
}

__global__ void __launch_bounds__(NTHREADS, 2) fwd_kernel(Params p) {
    extern __shared__ __attribute__((aligned(16))) unsigned char lds_raw[];
    LAS unsigned char* lds = (LAS unsigned char*)lds_raw;
    volatile LAS unsigned* MISC = (volatile LAS unsigned*)(lds + LDS_MISC);
    const int tid = threadIdx.x, wave_s = __builtin_amdgcn_readfirstlane(tid >> 6);
    const int G = gridDim.x, bx = blockIdx.x, vcu = (G % 8 == 0) ? (bx % 8) * (G / 8) + bx / 8 : bx;
    if (tid < 64) MISC[tid] = 0u;
    __syncthreads();
    unsigned* ctl = (unsigned*)(p.ws + WS_CTL);
    XcdBarrier bar = xcd_barrier_post(ctl + CW_BAR, MISC + 8, wave_s);
    unsigned char* ws = p.ws;
    bf16_t* WIN = (bf16_t*)(ws + WS_WIN); const float* RSTD = (const float*)(ws + WS_RSTD);
    const float* CS = (const float*)(ws + WS_ROPE); const float* SN = CS + (size_t)SEQ * 128; const float* CST = SN + (size_t)SEQ * 128; const float* SNT = CST + (size_t)SEQ * 128;
    bf16_t* XB = (bf16_t*)(ws + WS_XB);

    p0_prologue(p, lds, vcu, G, wave_s);
    xcd_barrier(bar);
    { pg8::Gemm g{XB, D, 16, nullptr, WIN, M, 2048, D}; pg8::StaticOrder S; S.init(M, 2048, G, bx);
      EpiQK E{(bf16_t*)(ws + WS_QF), (bf16_t*)(ws + WS_KF), RSTD, CS, SN};
      pg8::gemm_phase(lds, g, S, E, wave_s); }
    { pg8::Gemm g{WIN + (size_t)1024 * D, D, 16, nullptr, XB, 3072, M, D}; pg8::StaticOrder S; S.init(3072, M, G, bx);
      EpiKVT E{(bf16_t*)(ws + WS_KT), (bf16_t*)p.out, RSTD, CST, SNT};
      pg8::gemm_phase(lds, g, S, E, wave_s); }
    xcd_barrier(bar);
    scan_phase(p, lds, bar, wave_s);
    xcd_barrier(bar);
    intra_phase(p, lds, wave_s);
    { pg8::Gemm g{XB, D, 16, nullptr, WIN + (size_t)4096 * D, M, 2048, D}; pg8::StaticOrder S; S.init(M, 2048, G, bx);
      EpiU E{(bf16_t*)(ws + WS_U), RSTD};
      pg8::gemm_phase(lds, g, S, E, wave_s); }
    xcd_barrier(bar);
    { pg8::Gemm g{XB, D, 16, nullptr, WIN + (size_t)6144 * D, M, 5120, D}; pg8::StaticOrder S; S.init(M, 5120, G, bx);
      EpiB E{(const bf16_t*)(ws + WS_U), (bf16_t*)(ws + WS_A1), (bf16_t*)(ws + WS_R), (bf16_t*)p.out, RSTD, p.w_conv};
      pg8::gemm_phase(lds, g, S, E, wave_s); }
    xcd_barrier(bar);
    { pg8::Gemm g{(const bf16_t*)(ws + WS_A1), D, 16, (const bf16_t*)(ws + WS_R), (const bf16_t*)(ws + WS_WAR), M, D, 3072}; pg8::StaticOrder S; S.init(M, D, G, bx);
      EpiMerge E{(const bf16_t*)p.out, (bf16_t*)(ws + WS_MG)};
      pg8::gemm_phase(lds, g, S, E, wave_s); }
    xcd_barrier(bar);
    { pg8::Gemm g{(const bf16_t*)(ws + WS_MG), D, 16, nullptr, (const bf16_t*)(ws + WS_WO), M, D, D}; pg8::StaticOrder S; S.init(M, D, G, bx);
      EpiRes<true> E{p.x, p.out, (bf16_t*)(ws + WS_X1B), (float*)(ws + WS_SS1)};
      pg8::gemm_phase(lds, g, S, E, wave_s); }
    xcd_barrier(bar);
    { pg8::Gemm g{(const bf16_t*)(ws + WS_X1B), D, 16, nullptr, (const bf16_t*)(ws + WS_WGU), M, 2 * DFF, D}; pg8::StaticOrder S; S.init(M, 2 * DFF, G, bx);
      EpiGU E{(bf16_t*)(ws + WS_ACT), (const float*)(ws + WS_SS1)};
      pg8::gemm_phase(lds, g, S, E, wave_s); }
    xcd_barrier(bar);
    { pg8::Gemm g{(const bf16_t*)(ws + WS_ACT), DFF, DFF / 64, nullptr, (const bf16_t*)(ws + WS_WD), M, D, DFF}; pg8::StaticOrder S; S.init(M, D, G, bx);
      EpiRes<false> E{p.out, p.out, nullptr, (float*)(ws + WS_SS2)};
      pg8::gemm_phase(lds, g, S, E, wave_s); }
    xcd_barrier(bar);
    final_phase(p, vcu, G, wave_s);
}

extern "C" void kernel_launch(void* const* d_in, const int* in_sizes, int n_in, void* d_out, int out_size, void* d_ws, size_t ws_size, hipStream_t stream) {
    static int grid = 0;
    if (grid == 0) {
        if (n_in != 15 || in_sizes[0] != M * D || out_size != M * D || ws_size < WS_END) { fprintf(stderr, "kernel_launch: unexpected shapes (n_in %d, in0 %d, out %d, ws %zu)\n", n_in, n_in > 0 ? in_sizes[0] : -1, out_size, ws_size); grid = -1; return; }
        int dev = 0, cus = 0, per_cu = 0;
        if (hipGetDevice(&dev) != hipSuccess || hipDeviceGetAttribute(&cus, hipDeviceAttributeMultiprocessorCount, dev) != hipSuccess) { grid = -1; return; }
        if (hipFuncSetAttribute((const void*)fwd_kernel, hipFuncAttributeMaxDynamicSharedMemorySize, LDS_BYTES) != hipSuccess) { fprintf(stderr, "kernel_launch: hipFuncSetAttribute failed\n"); grid = -1; return; }
        if (hipOccupancyMaxActiveBlocksPerMultiprocessor(&per_cu, (const void*)fwd_kernel, NTHREADS, LDS_BYTES) != hipSuccess || per_cu < 1) fprintf(stderr, "kernel_launch: occupancy query reports %d\n", per_cu);
        (void)hipGetLastError();
        grid = cus;
        if (grid != 256) { fprintf(stderr, "kernel_launch: this kernel needs a 256-CU device (got %d)\n", cus); grid = -1; return; }
    }
    if (grid < 0) return;
    if (hipMemsetAsync((char*)d_ws + WS_CTL, 0, CTL_ZERO_BYTES, stream) != hipSuccess) return;
    Params p{};
    p.x = (const float*)d_in[0]; p.g_mix = (const float*)d_in[1]; p.w_in = (const float*)d_in[2]; p.w_conv = (const float*)d_in[3]; p.dec_f = (const float*)d_in[4]; p.dec_b = (const float*)d_in[5];
    p.g_ret = (const float*)d_in[6]; p.w_a_out = (const float*)d_in[7]; p.w_r_out = (const float*)d_in[8]; p.w_o = (const float*)d_in[9]; p.g_ffn = (const float*)d_in[10];
    p.w_ff_gate = (const float*)d_in[11]; p.w_ff_up = (const float*)d_in[12]; p.w_ff_down = (const float*)d_in[13]; p.g_final = (const float*)d_in[14];
    p.out = (float*)d_out; p.ws = (unsigned char*)d_ws;
    hipLaunchKernelGGL(fwd_kernel, dim3(grid), dim3(NTHREADS), LDS_BYTES, stream, p);
}
```

```cpp
#include <hip/hip_runtime.h>
#include <cstdio>
#include <cstdint>

#define GAS __attribute__((address_space(1)))
#define LAS __attribute__((address_space(3)))
typedef unsigned short bf16_t;
typedef short bf16x8 __attribute__((ext_vector_type(8)));
typedef float f32x4 __attribute__((ext_vector_type(4)));
typedef float f32x16 __attribute__((ext_vector_type(16)));
typedef unsigned u32x4 __attribute__((ext_vector_type(4)));
typedef unsigned u32x2 __attribute__((ext_vector_type(2)));
typedef float f32x2_t __attribute__((ext_vector_type(2)));
typedef __bf16 bf16x2_t __attribute__((ext_vector_type(2)));
typedef GAS unsigned gu32;

constexpr int BATCH = 2, SEQ = 8192, D = 1024, M = BATCH * SEQ, NIN = 11264, DFF = 2816;
constexpr int NH = 4, DK = 256, DV = 512, CH = 128, NCH = SEQ / CH, NGC = M / CH;
constexpr float EPS = 1e-6f;
constexpr int NWAVES = 8, NTHREADS = 512;

__device__ __forceinline__ unsigned cvtpk(float lo, float hi) { f32x2_t v = {lo, hi}; bf16x2_t b = __builtin_convertvector(v, bf16x2_t); return __builtin_bit_cast(unsigned, b); }
__device__ __forceinline__ float bflo(unsigned u) { return __uint_as_float(u << 16); }
__device__ __forceinline__ float bfhi(unsigned u) { return __uint_as_float(u & 0xffff0000u); }
__device__ __forceinline__ float sigmoidf_(float x) { return 1.0f / (1.0f + __expf(-x)); }
__device__ __forceinline__ float siluf_(float x) { return x / (1.0f + __expf(-x)); }
__device__ __forceinline__ float wave_sum(float v) {
#pragma unroll
    for (int o = 1; o < 64; o <<= 1) v += __shfl_xor(v, o);
    return v;
}
__device__ __forceinline__ int lane_id() { int l; asm volatile("v_mbcnt_lo_u32_b32 %0, -1, 0\n\tv_mbcnt_hi_u32_b32 %0, -1, %0" : "=v"(l)); return l; }
__device__ __forceinline__ int opaque_tid(int wave_s) { int t = wave_s * 64 + lane_id(); asm volatile("" : "+v"(t)); return t; }
#define LDS_WAIT() asm volatile("s_waitcnt lgkmcnt(0)" ::: "memory")
#define VM_WAIT() asm volatile("s_waitcnt vmcnt(0)" ::: "memory")
#define RLX_AGENT __ATOMIC_RELAXED, __HIP_MEMORY_SCOPE_AGENT

namespace pg8 {
constexpr int BM = 256, BK = 64, HALF = 128, HTB = HALF * BK * 2, STAGE_BYTES = 8 * HTB, NXCD = 8, WGM = 8;
__host__ __device__ __forceinline__ int lds_byte(int r, int c) { const int st = (r >> 4) * 2 + (c >> 5), rr = r & 15, cc = c & 31, ob = rr * 64 + cc * 2; return st * 1024 + (ob ^ (((ob >> 9) & 1) << 5)); }
__host__ __device__ __forceinline__ void stage_rc(int b, int& R, int& C) { const int st = b / 1024, sb = b % 1024, swz = sb ^ (((sb >> 9) & 1) << 5); R = (st >> 1) * 16 + swz / 64; C = (st & 1) * 32 + (swz % 64) / 2; }
__host__ __device__ __forceinline__ int perm32(int rho) { const int n = rho >> 4, i = rho & 15; return 8 * (i >> 2) + 4 * n + (i & 3); }

struct Unit { int pm, pn; };
struct Gemm { const bf16_t* A1; int lda1; int nt1; const bf16_t* A2; const bf16_t* Bt; int M, N, K; };

struct StaticOrder {
    int nM, nN, nwg, G, c;
    __device__ void init(int M_, int N_, int G_, int c_) { nM = M_ / BM; nN = N_ / BM; nwg = nM * nN; G = G_; c = c_; }
    __device__ bool next(int i, Unit& u) const {
        const long L = (long)i * G + c; if (L >= nwg) return false;
        int wgid = (int)L; { const int q = nwg / NXCD, r = nwg % NXCD, xcd = wgid % NXCD, off = wgid / NXCD; wgid = (xcd < r ? xcd * (q + 1) : r * (q + 1) + (xcd - r) * q) + off; }
        const int nig = WGM * nN, gid = wgid / nig, fm = gid * WGM, gsz = (nM - fm) < WGM ? (nM - fm) : WGM;
        u.pm = fm + ((wgid % nig) % gsz); u.pn = (wgid % nig) / gsz; return true;
    }
};

template <class Epi, class Sched>
__device__ __forceinline__ void gemm_phase(LAS unsigned char* lds, const Gemm g, const Sched& S, const Epi& E, int wave_s) {
    const int tid = opaque_tid(wave_s), wid = wave_s, lane = tid & 63, wr = wid >> 2, wc = wid & 3, fr = lane & 15, fq = lane >> 4;
    const int K = g.K, nt = K / BK, nt1 = g.nt1;
    unsigned voffA[2], voffA2[2], voffB[2];
#pragma unroll
    for (int i = 0; i < 2; ++i) { int R, C; stage_rc(tid * 16 + i * 8192, R, C); const int Rb = (R & ~31) + perm32(R & 31);
        voffA[i] = (unsigned)(R * g.lda1 + C) * 2u; voffB[i] = (unsigned)(Rb * K + C) * 2u;
        voffA2[i] = (unsigned)((C >> 5) * 4096 + (R >> 5) * 1024 + (R & 31) * 32 + (C & 31)) * 2u; }
    const size_t hs1 = (size_t)HALF * g.lda1 * 2, hs2 = (size_t)64 * 4096 * 2;
    const size_t hsB = (size_t)HALF * K * 2;
    const uintptr_t a1base = (uintptr_t)g.A1, a2base = (uintptr_t)g.A2;
    const unsigned ldsw = (unsigned)wid * 1024u;
    const int aoff = lds_byte(wr * 64 + fr, fq * 8), boff = lds_byte(wc * 32 + fr, fq * 8);
#define PG8_SA(b, h) (((b) * 2 + (h)) * HTB)
#define PG8_SB(b, h) ((4 + (b) * 2 + (h)) * HTB)
#define PG8_GLDS(gp, slot, i) __builtin_amdgcn_global_load_lds((const unsigned*)(gp), (LAS unsigned*)(lds + (slot) + ldsw + (i) * 8192), 16, 0, 0)
#define PG8_STAGE_A(slot, pm_, t_, hf) do { const int _t = (t_); const bool _s1 = _t < nt1; \
        const uintptr_t _gb = _s1 ? a1base + (size_t)(2 * (pm_) + (hf)) * hs1 + (size_t)_t * 128 \
                                  : a2base + (size_t)(2 * (pm_) + (hf)) * hs2 + (size_t)(_t - nt1) * 16384; \
        const unsigned _v0 = _s1 ? voffA[0] : voffA2[0], _v1 = _s1 ? voffA[1] : voffA2[1]; \
        PG8_GLDS(_gb + _v0, slot, 0); PG8_GLDS(_gb + _v1, slot, 1); } while (0)
#define PG8_STAGE_B(slot, pn_, t_, hf) do { const char* _gb = (const char*)g.Bt + (size_t)(pn_) * 2 * hsB + (size_t)(hf) * hsB + (size_t)(t_) * 128; \
        PG8_GLDS(_gb + voffB[0], slot, 0); PG8_GLDS(_gb + voffB[1], slot, 1); } while (0)
#define PG8_LDA(dst, b, h) do { _Pragma("unroll") for (int m = 0; m < 4; ++m) _Pragma("unroll") for (int k = 0; k < 2; ++k) dst[m][k] = *(const LAS bf16x8*)(lds + PG8_SA(b, h) + aoff + m * 2048 + k * 1024); } while (0)
#define PG8_LDB(dst, b, h) do { _Pragma("unroll") for (int n = 0; n < 2; ++n) _Pragma("unroll") for (int k = 0; k < 2; ++k) dst[n][k] = *(const LAS bf16x8*)(lds + PG8_SB(b, h) + boff + n * 2048 + k * 1024); } while (0)
#define PG8_MMA(ai, bj, At, Bt) do { __builtin_amdgcn_s_setprio(1); _Pragma("unroll") for (int m = 0; m < 4; ++m) _Pragma("unroll") for (int n = 0; n < 2; ++n) _Pragma("unroll") for (int k = 0; k < 2; ++k) \
        acc[ai][bj][m][n] = __builtin_amdgcn_mfma_f32_16x16x32_bf16(Bt[n][k], At[m][k], acc[ai][bj][m][n], 0, 0, 0); __builtin_amdgcn_s_setprio(0); } while (0)
#define PG8_WAIT_V(n) asm volatile("s_waitcnt vmcnt(" #n ")" ::: "memory")
#define PG8_WAIT_L(n) asm volatile("s_waitcnt lgkmcnt(" #n ")" ::: "memory")
#define PG8_BAR __builtin_amdgcn_s_barrier()
#define PG8_SCHED __builtin_amdgcn_sched_barrier(0)
    Unit cur, nxt; int ui = 0;
    if (!S.next(0, cur)) return;
    f32x4 acc[2][2][4][2];
#pragma unroll
    for (int a = 0; a < 2; ++a)
#pragma unroll
        for (int b = 0; b < 2; ++b)
#pragma unroll
            for (int m = 0; m < 4; ++m)
#pragma unroll
                for (int n = 0; n < 2; ++n) acc[a][b][m][n] = (f32x4){0.f, 0.f, 0.f, 0.f};
    bf16x8 At[4][2], B0[2][2], B1[2][2];
    PG8_STAGE_B(PG8_SB(0, 0), cur.pn, 0, 0); PG8_STAGE_B(PG8_SB(0, 1), cur.pn, 0, 1); PG8_STAGE_A(PG8_SA(0, 0), cur.pm, 0, 0); PG8_STAGE_A(PG8_SA(0, 1), cur.pm, 0, 1);
    if (wr == 1) PG8_BAR;
    PG8_WAIT_V(2); PG8_BAR;
    PG8_STAGE_B(PG8_SB(1, 0), cur.pn, 1, 0); PG8_STAGE_A(PG8_SA(1, 0), cur.pm, 1, 0); PG8_STAGE_B(PG8_SB(1, 1), cur.pn, 1, 1);
    PG8_WAIT_V(6); PG8_BAR;
    for (;;) {
        const bool has_next = S.next(ui + 1, nxt);
        const int npm = has_next ? nxt.pm : cur.pm, npn = has_next ? nxt.pn : cur.pn;
        for (int t = 0; t < nt; t += 2) {
            const bool last = (t == nt - 2);
            const int pm2 = last ? npm : cur.pm, pn2 = last ? npn : cur.pn, t2 = last ? 0 : t + 2, t3 = t2 + 1;
            if constexpr (Epi::MID) { if (t == nt1 && nt1 < nt) { int fr_e = fr, fq_e = fq; asm volatile("" : "+v"(fr_e), "+v"(fq_e)); E.mid(acc, cur, wr, wc, fr_e, fq_e); } }
            PG8_LDB(B0, 0, 0); PG8_LDB(B1, 0, 1); PG8_SCHED; PG8_LDA(At, 0, 0); PG8_STAGE_A(PG8_SA(1, 1), cur.pm, t + 1, 1);
            PG8_WAIT_V(8); PG8_WAIT_L(0); PG8_BAR; PG8_MMA(0, 0, At, B0); PG8_MMA(0, 1, At, B1); PG8_BAR; PG8_SCHED;
            PG8_LDA(At, 0, 1); PG8_STAGE_B(PG8_SB(0, 0), pn2, t2, 0); PG8_STAGE_B(PG8_SB(0, 1), pn2, t2, 1); PG8_STAGE_A(PG8_SA(0, 0), pm2, t2, 0);
            PG8_WAIT_V(8); PG8_WAIT_L(0); PG8_BAR; PG8_MMA(1, 0, At, B0); PG8_MMA(1, 1, At, B1); PG8_BAR; PG8_SCHED;
            PG8_LDB(B0, 1, 0); PG8_LDB(B1, 1, 1); PG8_SCHED; PG8_LDA(At, 1, 0); PG8_STAGE_A(PG8_SA(0, 1), pm2, t2, 1);
            PG8_WAIT_V(8); PG8_WAIT_L(0); PG8_BAR; PG8_MMA(0, 0, At, B0); PG8_MMA(0, 1, At, B1); PG8_BAR; PG8_SCHED;
            PG8_LDA(At, 1, 1); PG8_STAGE_B(PG8_SB(1, 0), pn2, t3, 0); PG8_STAGE_B(PG8_SB(1, 1), pn2, t3, 1); PG8_STAGE_A(PG8_SA(1, 0), pm2, t3, 0);
            PG8_WAIT_V(8); PG8_WAIT_L(0); PG8_BAR; PG8_MMA(1, 0, At, B0); PG8_MMA(1, 1, At, B1); PG8_BAR; PG8_SCHED;
        }
        if (wr == 0) PG8_BAR;
        { int fr_e = fr, fq_e = fq; asm volatile("" : "+v"(fr_e), "+v"(fq_e));
          E(acc, cur, wr, wc, fr_e, fq_e); }
        if (!has_next) break;
#pragma unroll
        for (int a = 0; a < 2; ++a)
#pragma unroll
            for (int b = 0; b < 2; ++b)
#pragma unroll
                for (int m = 0; m < 4; ++m)
#pragma unroll
                    for (int n = 0; n < 2; ++n) acc[a][b][m][n] = (f32x4){0.f, 0.f, 0.f, 0.f};
        cur = nxt; ++ui;
        if (wr == 1) PG8_BAR;
    }
    PG8_WAIT_V(0);
    PG8_BAR;
#undef PG8_SA
#undef PG8_SB
#undef PG8_GLDS
#undef PG8_STAGE_A
#undef PG8_STAGE_B
#undef PG8_LDA
#undef PG8_LDB
#undef PG8_MMA
#undef PG8_WAIT_V
#undef PG8_WAIT_L
#undef PG8_BAR
#undef PG8_SCHED
}
}
__device__ __forceinline__ size_t qf_off(int m, int h, int d0  ) {
    const int gc = m >> 7, tt = (m >> 5) & 3, r = m & 31, kd = d0 >> 4, hh = (d0 >> 3) & 1;
    return ((((size_t)(gc * 4 + h) * 4 + tt) * 16 + kd) * 64 + hh * 32 + r) * 8;
}

struct EpiQK {
    static constexpr bool MID = false;
    bf16_t* QF; bf16_t* KF; const float* rstd; const float* CS; const float* SN;
    __device__ __forceinline__ void mid(f32x4 (&)[2][2][4][2], const pg8::Unit&, int, int, int, int) const {}
    __device__ __forceinline__ void operator()(const f32x4 (&acc)[2][2][4][2], const pg8::Unit& u, int wr, int wc, int fr, int fq) const {
        const bool isq = u.pn < 4; const int h = u.pn & 3; bf16_t* dst = isq ? QF : KF; const float osc = isq ? 0.0625f : 1.0f;
        const int jf0 = wc * 32 + 8 * fq;
#pragma unroll
        for (int ai = 0; ai < 2; ++ai)
#pragma unroll
            for (int m = 0; m < 4; ++m) {
                const int row = u.pm * 256 + ai * 128 + wr * 64 + m * 16 + fr, pos = row & (SEQ - 1);
                const float rs = rstd[row] * osc;
                const f32x4 c0 = *(const f32x4*)(CS + (size_t)pos * 128 + jf0), c1 = *(const f32x4*)(CS + (size_t)pos * 128 + jf0 + 4);
                const f32x4 s0 = *(const f32x4*)(SN + (size_t)pos * 128 + jf0), s1 = *(const f32x4*)(SN + (size_t)pos * 128 + jf0 + 4);
                const f32x4 a0 = acc[ai][0][m][0] * rs, a1 = acc[ai][0][m][1] * rs, b0 = acc[ai][1][m][0] * rs, b1 = acc[ai][1][m][1] * rs;
                const f32x4 o10 = a0 * c0 - b0 * s0, o11 = a1 * c1 - b1 * s1, o20 = a0 * s0 + b0 * c0, o21 = a1 * s1 + b1 * c1;
                u32x4 w1, w2;
                w1.x = cvtpk(o10[0], o10[1]); w1.y = cvtpk(o10[2], o10[3]); w1.z = cvtpk(o11[0], o11[1]); w1.w = cvtpk(o11[2], o11[3]);
                w2.x = cvtpk(o20[0], o20[1]); w2.y = cvtpk(o20[2], o20[3]); w2.z = cvtpk(o21[0], o21[1]); w2.w = cvtpk(o21[2], o21[3]);
                *(u32x4*)(dst + qf_off(row, h, jf0)) = w1;
                *(u32x4*)(dst + qf_off(row, h, 128 + jf0)) = w2;
            }
    }
};

struct EpiKVT {
    static constexpr bool MID = false;
    bf16_t* KT; bf16_t* VT; const float* rstd; const float* CST; const float* SNT;
    __device__ __forceinline__ void mid(f32x4 (&)[2][2][4][2], const pg8::Unit&, int, int, int, int) const {}
    __device__ __forceinline__ void operator()(const f32x4 (&acc)[2][2][4][2], const pg8::Unit& u, int wr, int wc, int fr, int fq) const {
        if (u.pm < 4) {
            const int h = u.pm;
#pragma unroll
            for (int bj = 0; bj < 2; ++bj) {
                const int tok0 = u.pn * 256 + bj * 128 + wc * 32 + 8 * fq, gc = tok0 >> 7, s0 = tok0 & 127, pos0 = tok0 & (SEQ - 1);
                const int ks = s0 >> 4, jhi = (s0 >> 3) & 1;
                const f32x4 r0 = *(const f32x4*)(rstd + tok0), r1 = *(const f32x4*)(rstd + tok0 + 4);
#pragma unroll
                for (int m = 0; m < 4; ++m) {
                    const int jf = wr * 64 + m * 16 + fr;
                    const f32x4 c0 = *(const f32x4*)(CST + (size_t)jf * SEQ + pos0), c1 = *(const f32x4*)(CST + (size_t)jf * SEQ + pos0 + 4);
                    const f32x4 s0v = *(const f32x4*)(SNT + (size_t)jf * SEQ + pos0), s1v = *(const f32x4*)(SNT + (size_t)jf * SEQ + pos0 + 4);
                    const f32x4 a0 = acc[0][bj][m][0] * r0, a1 = acc[0][bj][m][1] * r1, b0 = acc[1][bj][m][0] * r0, b1 = acc[1][bj][m][1] * r1;
                    const f32x4 o10 = a0 * c0 - b0 * s0v, o11 = a1 * c1 - b1 * s1v, o20 = a0 * s0v + b0 * c0, o21 = a1 * s1v + b1 * c1;
#pragma unroll
                    for (int half = 0; half < 2; ++half) {
                        const int d = half * 128 + jf, dt = d >> 5, dl = d & 31;
                        const size_t base = ((((size_t)(gc * 4 + h) * 8 + dt) * 8 + ks) * 64) * 8 + 4 * jhi;
                        const f32x4 v0 = half ? o20 : o10, v1 = half ? o21 : o11;
                        u32x2 w0, w1; w0.x = cvtpk(v0[0], v0[1]); w0.y = cvtpk(v0[2], v0[3]); w1.x = cvtpk(v1[0], v1[1]); w1.y = cvtpk(v1[2], v1[3]);
                        *(u32x2*)(KT + base + (size_t)(dl) * 8) = w0;
                        *(u32x2*)(KT + base + (size_t)(32 + dl) * 8) = w1;
                    }
                    asm volatile("" ::: "memory");
                }
            }
        } else {
#pragma unroll
            for (int bj = 0; bj < 2; ++bj) {
                const int tok0 = u.pn * 256 + bj * 128 + wc * 32 + 8 * fq, gc = tok0 >> 7, s0 = tok0 & 127;
                const int ks = s0 >> 4, jhi = (s0 >> 3) & 1;
                const f32x4 r0 = *(const f32x4*)(rstd + tok0), r1 = *(const f32x4*)(rstd + tok0 + 4);
#pragma unroll
                for (int ai = 0; ai < 2; ++ai)
#pragma unroll
                    for (int m = 0; m < 4; ++m) {
                        const int eg = (u.pm - 4) * 256 + ai * 128 + wr * 64 + m * 16 + fr, h = eg >> 9, e = eg & 511, et = e >> 5, el = e & 31;
                        const size_t base = ((((size_t)(gc * 4 + h) * 16 + et) * 8 + ks) * 64) * 8 + 4 * jhi;
                        const f32x4 v0 = acc[ai][bj][m][0] * r0, v1 = acc[ai][bj][m][1] * r1;
                        u32x2 w0, w1; w0.x = cvtpk(v0[0], v0[1]); w0.y = cvtpk(v0[2], v0[3]); w1.x = cvtpk(v1[0], v1[1]); w1.y = cvtpk(v1[2], v1[3]);
                        *(u32x2*)(VT + base + (size_t)(el) * 8) = w0;
                        *(u32x2*)(VT + base + (size_t)(32 + el) * 8) = w1;
                        asm volatile("" ::: "memory");
                    }
            }
        }
    }
};

struct EpiU {
    static constexpr bool MID = false;
    bf16_t* U; const float* rstd;
    __device__ __forceinline__ void mid(f32x4 (&)[2][2][4][2], const pg8::Unit&, int, int, int, int) const {}
    __device__ __forceinline__ void operator()(const f32x4 (&acc)[2][2][4][2], const pg8::Unit& u, int wr, int wc, int fr, int fq) const {
        const int col0 = u.pn * 128 + wc * 32 + 8 * fq;
#pragma unroll
        for (int ai = 0; ai < 2; ++ai)
#pragma unroll
            for (int m = 0; m < 4; ++m) {
                const int row = u.pm * 256 + ai * 128 + wr * 64 + m * 16 + fr; const float rs = rstd[row], r2 = rs * rs;
                const f32x4 v0 = acc[ai][0][m][0] * acc[ai][1][m][0] * r2, v1 = acc[ai][0][m][1] * acc[ai][1][m][1] * r2;
                u32x4 w; w.x = cvtpk(v0[0], v0[1]); w.y = cvtpk(v0[2], v0[3]); w.z = cvtpk(v1[0], v1[1]); w.w = cvtpk(v1[2], v1[3]);
                *(u32x4*)(U + (size_t)row * D + col0) = w;
            }
    }
};

__device__ __forceinline__ size_t zb_off(int m, int col  ) { return (((size_t)((m >> 7) * 64 + (col >> 5)) * 4 + ((m >> 5) & 3)) * 1024) + (m & 31) * 32 + (col & 31); }
__device__ __forceinline__ void unpack8(const u32x4 w, float (&f)[8]) { f[0] = bflo(w.x); f[1] = bfhi(w.x); f[2] = bflo(w.y); f[3] = bfhi(w.y); f[4] = bflo(w.z); f[5] = bfhi(w.z); f[6] = bflo(w.w); f[7] = bfhi(w.w); }

struct EpiB {
    static constexpr bool MID = false;
    const bf16_t* U; bf16_t* A1; bf16_t* ZB; bf16_t* SG; const float* rstd; const float* wconv;
    __device__ __forceinline__ void mid(f32x4 (&)[2][2][4][2], const pg8::Unit&, int, int, int, int) const {}
    __device__ __forceinline__ void operator()(const f32x4 (&acc)[2][2][4][2], const pg8::Unit& u, int wr, int wc, int fr, int fq) const {
        const int cl = wc * 32 + 8 * fq;
        if (u.pn < 4) {
#pragma unroll
            for (int bj = 0; bj < 2; ++bj) {
                const int ch0 = u.pn * 256 + bj * 128 + cl;
                float w0[8], w1[8], w2[8];
#pragma unroll
                for (int i = 0; i < 8; ++i) { w0[i] = wconv[ch0 + i]; w1[i] = wconv[D + ch0 + i]; w2[i] = wconv[2 * D + ch0 + i]; }
#pragma unroll
                for (int ai = 0; ai < 2; ++ai)
#pragma unroll
                    for (int m = 0; m < 4; ++m) {
                        const int row = u.pm * 256 + ai * 128 + wr * 64 + m * 16 + fr, pos = row & (SEQ - 1); const float rs = rstd[row];
                        const u32x4 uc = *(const u32x4*)(U + (size_t)row * D + ch0);
                        u32x4 up = (u32x4){0u, 0u, 0u, 0u}, un = (u32x4){0u, 0u, 0u, 0u};
                        if (pos > 0) up = *(const u32x4*)(U + (size_t)(row - 1) * D + ch0);
                        if (pos < SEQ - 1) un = *(const u32x4*)(U + (size_t)(row + 1) * D + ch0);
                        float fc[8], fp[8], fn[8]; unpack8(uc, fc); unpack8(up, fp); unpack8(un, fn);
                        float o[8];
#pragma unroll
                        for (int i = 0; i < 8; ++i) { const float a = (i < 4) ? acc[ai][bj][m][0][i & 3] : acc[ai][bj][m][1][i & 3]; o[i] = (a * rs) * (fp[i] * w0[i] + fc[i] * w1[i] + fn[i] * w2[i]); }
                        u32x4 w; w.x = cvtpk(o[0], o[1]); w.y = cvtpk(o[2], o[3]); w.z = cvtpk(o[4], o[5]); w.w = cvtpk(o[6], o[7]);
                        *(u32x4*)(A1 + (size_t)row * D + ch0) = w;
                    }
            }
        } else if (u.pn < 12) {
#pragma unroll
            for (int ai = 0; ai < 2; ++ai)
#pragma unroll
                for (int m = 0; m < 4; ++m) {
                    const int row = u.pm * 256 + ai * 128 + wr * 64 + m * 16 + fr; const float rs = rstd[row];
#pragma unroll
                    for (int bj = 0; bj < 2; ++bj) {
                        const int col0 = (u.pn - 4) * 256 + bj * 128 + cl; bf16_t* zp = ZB + zb_off(row, col0);
                        const u32x4 z = *(const u32x4*)zp; float zf[8]; unpack8(z, zf); float o[8];
#pragma unroll
                        for (int i = 0; i < 8; ++i) { const float a = ((i < 4) ? acc[ai][bj][m][0][i & 3] : acc[ai][bj][m][1][i & 3]) * rs; o[i] = zf[i] * siluf_(a); }
                        u32x4 w; w.x = cvtpk(o[0], o[1]); w.y = cvtpk(o[2], o[3]); w.z = cvtpk(o[4], o[5]); w.w = cvtpk(o[6], o[7]);
                        *(u32x4*)zp = w;
                    }
                }
        } else {
#pragma unroll
            for (int ai = 0; ai < 2; ++ai)
#pragma unroll
                for (int m = 0; m < 4; ++m) {
                    const int row = u.pm * 256 + ai * 128 + wr * 64 + m * 16 + fr; const float rs = rstd[row];
#pragma unroll
                    for (int bj = 0; bj < 2; ++bj) {
                        const int col0 = (u.pn - 12) * 256 + bj * 128 + cl; float o[8];
#pragma unroll
                        for (int i = 0; i < 8; ++i) { const float a = ((i < 4) ? acc[ai][bj][m][0][i & 3] : acc[ai][bj][m][1][i & 3]) * rs; o[i] = sigmoidf_(a); }
                        u32x4 w; w.x = cvtpk(o[0], o[1]); w.y = cvtpk(o[2], o[3]); w.z = cvtpk(o[4], o[5]); w.w = cvtpk(o[6], o[7]);
                        *(u32x4*)(SG + (size_t)row * 2048 + col0) = w;
                    }
                }
        }
    }
};

struct EpiMerge {
    static constexpr bool MID = true;
    const bf16_t* SG; bf16_t* MG;
    __device__ __forceinline__ void mid(f32x4 (&acc)[2][2][4][2], const pg8::Unit& u, int wr, int wc, int fr, int fq) const {
#pragma unroll
        for (int ai = 0; ai < 2; ++ai)
#pragma unroll
            for (int m = 0; m < 4; ++m) {
                const int row = u.pm * 256 + ai * 128 + wr * 64 + m * 16 + fr;
#pragma unroll
                for (int bj = 0; bj < 2; ++bj) {
                    const int col0 = u.pn * 256 + bj * 128 + wc * 32 + 8 * fq;
                    const u32x4 sa = *(const u32x4*)(SG + (size_t)row * 2048 + col0), sr = *(const u32x4*)(SG + (size_t)row * 2048 + 1024 + col0);
                    float fa[8], fr_[8]; unpack8(sa, fa); unpack8(sr, fr_);
#pragma unroll
                    for (int i = 0; i < 4; ++i) { acc[ai][bj][m][0][i] *= fa[i] / fr_[i]; acc[ai][bj][m][1][i] *= fa[4 + i] / fr_[4 + i]; }
                }
            }
    }
    __device__ __forceinline__ void operator()(const f32x4 (&acc)[2][2][4][2], const pg8::Unit& u, int wr, int wc, int fr, int fq) const {
#pragma unroll
        for (int ai = 0; ai < 2; ++ai)
#pragma unroll
            for (int m = 0; m < 4; ++m) {
                const int row = u.pm * 256 + ai * 128 + wr * 64 + m * 16 + fr;
#pragma unroll
                for (int bj = 0; bj < 2; ++bj) {
                    const int col0 = u.pn * 256 + bj * 128 + wc * 32 + 8 * fq;
                    const u32x4 sr = *(const u32x4*)(SG + (size_t)row * 2048 + 1024 + col0); float f[8]; unpack8(sr, f);
                    const f32x4 v0 = acc[ai][bj][m][0], v1 = acc[ai][bj][m][1];
                    u32x4 w; w.x = cvtpk(v0[0] * f[0], v0[1] * f[1]); w.y = cvtpk(v0[2] * f[2], v0[3] * f[3]); w.z = cvtpk(v1[0] * f[4], v1[1] * f[5]); w.w = cvtpk(v1[2] * f[6], v1[3] * f[7]);
                    *(u32x4*)(MG + (size_t)row * D + col0) = w;
                }
            }
    }
};

template <bool WRITE_BF> struct EpiRes {
    static constexpr bool MID = false;
    const float* xin; float* xo; bf16_t* xb; float* SS;
    __device__ __forceinline__ void mid(f32x4 (&)[2][2][4][2], const pg8::Unit&, int, int, int, int) const {}
    __device__ __forceinline__ void operator()(const f32x4 (&acc)[2][2][4][2], const pg8::Unit& u, int wr, int wc, int fr, int fq) const {
#pragma unroll
        for (int ai = 0; ai < 2; ++ai)
#pragma unroll
            for (int m = 0; m < 4; ++m) {
                const int row = u.pm * 256 + ai * 128 + wr * 64 + m * 16 + fr; float ss = 0.f;
#pragma unroll
                for (int bj = 0; bj < 2; ++bj) {
                    const int col0 = u.pn * 256 + bj * 128 + wc * 32 + 8 * fq; const size_t off = (size_t)row * D + col0;
                    const f32x4 v0 = *(const f32x4*)(xin + off) + acc[ai][bj][m][0], v1 = *(const f32x4*)(xin + off + 4) + acc[ai][bj][m][1];
                    *(f32x4*)(xo + off) = v0; *(f32x4*)(xo + off + 4) = v1;
                    ss += (v0[0] * v0[0] + v0[1] * v0[1]) + (v0[2] * v0[2] + v0[3] * v0[3]) + (v1[0] * v1[0] + v1[1] * v1[1]) + (v1[2] * v1[2] + v1[3] * v1[3]);
                    if (WRITE_BF) { u32x4 w; w.x = cvtpk(v0[0], v0[1]); w.y = cvtpk(v0[2], v0[3]); w.z = cvtpk(v1[0], v1[1]); w.w = cvtpk(v1[2], v1[3]); *(u32x4*)(xb + off) = w; }
                }
                ss += __shfl_xor(ss, 16); ss += __shfl_xor(ss, 32);
                if (fq == 0) SS[(size_t)row * 16 + u.pn * 4 + wc] = ss;
            }
    }
};

struct EpiGU {
    static constexpr bool MID = false;
    bf16_t* ACT; const float* SS;
    __device__ __forceinline__ void mid(f32x4 (&)[2][2][4][2], const pg8::Unit&, int, int, int, int) const {}
    __device__ __forceinline__ void operator()(const f32x4 (&acc)[2][2][4][2], const pg8::Unit& u, int wr, int wc, int fr, int fq) const {
        const int col0 = u.pn * 128 + wc * 32 + 8 * fq;
#pragma unroll
        for (int ai = 0; ai < 2; ++ai)
#pragma unroll
            for (int m = 0; m < 4; ++m) {
                const int row = u.pm * 256 + ai * 128 + wr * 64 + m * 16 + fr;
                const f32x4 p0 = *(const f32x4*)(SS + (size_t)row * 16), p1 = *(const f32x4*)(SS + (size_t)row * 16 + 4), p2 = *(const f32x4*)(SS + (size_t)row * 16 + 8), p3 = *(const f32x4*)(SS + (size_t)row * 16 + 12);
                const f32x4 ps = (p0 + p1) + (p2 + p3); const float rs = 1.0f / sqrtf(((ps[0] + ps[1]) + (ps[2] + ps[3])) * (1.0f / D) + EPS);
                float o[8];
#pragma unroll
                for (int i = 0; i < 8; ++i) { const float gt = ((i < 4) ? acc[ai][0][m][0][i & 3] : acc[ai][0][m][1][i & 3]) * rs, up = ((i < 4) ? acc[ai][1][m][0][i & 3] : acc[ai][1][m][1][i & 3]) * rs; o[i] = siluf_(gt) * up; }
                u32x4 w; w.x = cvtpk(o[0], o[1]); w.y = cvtpk(o[2], o[3]); w.z = cvtpk(o[4], o[5]); w.w = cvtpk(o[6], o[7]);
                *(u32x4*)(ACT + (size_t)row * DFF + col0) = w;
            }
    }
};
#define XB_TMO      128
#define XB_XCNT(j)  (256  + 64 * (j))
#define XB_XSUB(j)  (1280 + 64 * (j))
#define XB_XGEN(j)  (2304 + 64 * (j))
#define XB_TOP      3328
#define XB_TOPGEN   3392
#define XCD_BAR_WORDS 3456
#define XB_SPIN_CAP (1u << 18)
__device__ __forceinline__ unsigned xb_ld(unsigned* p)              { return __hip_atomic_load(p, __ATOMIC_RELAXED, __HIP_MEMORY_SCOPE_AGENT); }
__device__ __forceinline__ unsigned xb_add(unsigned* p, unsigned v) { return __hip_atomic_fetch_add(p, v, __ATOMIC_RELAXED, __HIP_MEMORY_SCOPE_AGENT); }
__device__ __forceinline__ unsigned xb_xcc_id() { return (unsigned)__builtin_amdgcn_s_getreg((3 << 11) | 20) & 0xFu; }
#define XB_SPIN(cond, bar) do { unsigned _sp = 0; while (cond) { __builtin_amdgcn_s_sleep(1); \
    if ((++_sp & 255u) == 0u) { if (xb_ld(&(bar)[XB_TMO])) break; if (_sp > XB_SPIN_CAP) { atomicAdd(&(bar)[XB_TMO], 1u); break; } } } } while (0)
struct XcdBarrier { unsigned* bar; unsigned x; volatile LAS unsigned* st; int wave_s; };
__device__ __forceinline__ XcdBarrier xcd_barrier_post(unsigned* bar, volatile LAS unsigned* st, int wave_s) {
    XcdBarrier b; b.bar = bar; b.x = xb_xcc_id(); b.st = st; b.wave_s = wave_s;
    if (wave_s == 0 && lane_id() == 0) (void)xb_add(&bar[XB_XCNT(b.x)], 1u);
    return b;
}
__device__ __forceinline__ void xcd_barrier_complete(unsigned* bar, unsigned x, unsigned& nloc, unsigned& nx) {
    const unsigned G = gridDim.x * gridDim.y * gridDim.z;
    unsigned sum, cnt, mine, sp = 0u;
    for (;;) {
        sum = 0u; cnt = 0u; mine = 0u;
#pragma unroll
        for (unsigned j = 0; j < 16; ++j) { const unsigned c = xb_ld(&bar[XB_XCNT(j)]); sum += c; cnt += (c > 0u) ? 1u : 0u; mine = (j == x) ? c : mine; }
        if (sum == G) break;
        __builtin_amdgcn_s_sleep(1);
        if ((++sp & 255u) == 0u) { if (xb_ld(&bar[XB_TMO])) break; if (sp > XB_SPIN_CAP) { atomicAdd(&bar[XB_TMO], 1u); break; } }
    }
    nloc = mine > 0u ? mine : 1u; nx = cnt > 0u ? cnt : 1u;
}
__device__ __forceinline__ void xcd_barrier(const XcdBarrier& b) {
    asm volatile("s_waitcnt vmcnt(0)" ::: "memory");
    __syncthreads();
    if (b.wave_s == 0 && lane_id() == 0) {
        unsigned* bar = b.bar;
        __builtin_amdgcn_s_waitcnt(0);
        unsigned nloc = b.st[0], nx = b.st[1];
        if (nloc == 0u) { xcd_barrier_complete(bar, b.x, nloc, nx); b.st[0] = nloc; b.st[1] = nx; }
        const unsigned old = xb_add(&bar[XB_XSUB(b.x)], 1u);
        const unsigned gen = old / nloc;
        if (old + 1u == (gen + 1u) * nloc) {
            __builtin_amdgcn_fence(__ATOMIC_RELEASE, "agent");
            asm volatile("s_waitcnt vmcnt(0)" ::: "memory");
            const unsigned og = xb_add(&bar[XB_TOP], 1u);
            const unsigned tg = og / nx;
            if (og + 1u == (tg + 1u) * nx) xb_add(&bar[XB_TOPGEN], 1u);
            else XB_SPIN(xb_ld(&bar[XB_TOPGEN]) == tg, bar);
            __builtin_amdgcn_fence(__ATOMIC_ACQUIRE, "agent");
            xb_add(&bar[XB_XGEN(b.x)], 1u);
            asm volatile("s_waitcnt vmcnt(0)" ::: "memory");
        } else {
            XB_SPIN(xb_ld(&bar[XB_XGEN(b.x)]) == gen, bar);
            __builtin_amdgcn_fence(__ATOMIC_ACQUIRE, "agent");
            asm volatile("s_waitcnt vmcnt(0)" ::: "memory");
        }
    }
    __syncthreads();
}

constexpr size_t MiB = 1u << 20;
constexpr size_t WS_CTL = 0, CTL_ZERO_BYTES = 64 * 1024;
constexpr size_t WS_WIN = 1 * MiB;
constexpr size_t WS_WAR = 23 * MiB;
constexpr size_t WS_WO = 29 * MiB;
constexpr size_t WS_WGU = 31 * MiB;
constexpr size_t WS_WD = 42 * MiB;
constexpr size_t WS_RSTD = 48 * MiB;
constexpr size_t WS_SS1 = 49 * MiB;
constexpr size_t WS_SS2 = 50 * MiB;
constexpr size_t WS_XB = 51 * MiB;
constexpr size_t WS_QF = 83 * MiB;
constexpr size_t WS_KF = 115 * MiB;
constexpr size_t WS_KT = 147 * MiB;
constexpr size_t WS_ROPE = 179 * MiB;
constexpr size_t WS_R = 179 * MiB;
constexpr size_t WS_MG = WS_QF, WS_A1 = WS_KF, WS_X1B = WS_KF, WS_U = WS_KT, WS_ACT = WS_KT;
constexpr size_t WS_END = 256 * MiB;
static_assert(WS_R + 64 * MiB <= WS_END && WS_ACT + (size_t)M * DFF * 2 <= WS_END, "ws map");
constexpr int CW_BAR = 1024;

constexpr int LDS_MISC = 131072, LDS_BYTES = 147456;

struct Params {
    const float* x; const float* g_mix; const float* w_in; const float* w_conv; const float* dec_f; const float* dec_b; const float* g_ret;
    const float* w_a_out; const float* w_r_out; const float* w_o; const float* g_ffn; const float* w_ff_gate; const float* w_ff_up; const float* w_ff_down; const float* g_final;
    float* out; unsigned char* ws;
};

__device__ __forceinline__ void p0_tr_item(const float* W, int Nsrc, int k0, int n0s, bf16_t* dst, int ldd, int n0d, int koff, const float* gk, LAS float* scr, int lane) {
    const int c4 = lane & 7, kr = lane >> 3;
#pragma unroll
    for (int i = 0; i < 8; ++i) { const int kk = 8 * i + kr; const float g = gk ? gk[k0 + kk] : 1.0f;
        const f32x4 v = *(const f32x4*)(W + (size_t)(k0 + kk) * Nsrc + n0s + 4 * c4);
        LAS float* d = scr + kk * 33 + 4 * c4; d[0] = v.x * g; d[1] = v.y * g; d[2] = v.z * g; d[3] = v.w * g; }
    LDS_WAIT(); asm volatile("" ::: "memory");
    const int c = lane & 7;
#pragma unroll
    for (int j = 0; j < 4; ++j) { const int n = (lane >> 3) + 8 * j; const LAS float* s = scr + (8 * c) * 33 + n;
        u32x4 o; o.x = cvtpk(s[0 * 33], s[1 * 33]); o.y = cvtpk(s[2 * 33], s[3 * 33]); o.z = cvtpk(s[4 * 33], s[5 * 33]); o.w = cvtpk(s[6 * 33], s[7 * 33]);
        *(u32x4*)(dst + (size_t)(n0d + n) * ldd + koff + k0 + 8 * c) = o; }
    LDS_WAIT(); asm volatile("" ::: "memory");
}
__device__ __forceinline__ int win_src_col(int n0d) {
    if (n0d < 1024) return 3072 + n0d;
    if (n0d < 2048) return 4096 + (n0d - 1024);
    if (n0d < 4096) return 5120 + (n0d - 2048);
    if (n0d < 6144) { const int o = n0d - 4096, t = o >> 8, i = o & 255; return (i < 128) ? 128 * t + i : 2048 + 128 * t + (i - 128); }
    if (n0d < 7168) return 1024 + (n0d - 6144);
    return n0d;
}
__device__ __forceinline__ void sincos_d(float angf, float& sn, float& cs) {
    const double a = (double)angf; const double kq = __builtin_rint(a * 0.63661977236758134308);
    double r = __builtin_fma(-kq, 1.57079632679489655800, a); r = __builtin_fma(-kq, 6.12323399573676603587e-17, r);
    const double r2 = r * r;
    double s = -1.0 / 1307674368000.0; s = s * r2 + 1.0 / 6227020800.0; s = s * r2 - 1.0 / 39916800.0; s = s * r2 + 1.0 / 362880.0; s = s * r2 - 1.0 / 5040.0; s = s * r2 + 1.0 / 120.0; s = s * r2 - 1.0 / 6.0; s = s * r2 * r + r;
    double c = 1.0 / 20922789888000.0; c = c * r2 - 1.0 / 87178291200.0; c = c * r2 + 1.0 / 479001600.0; c = c * r2 - 1.0 / 3628800.0; c = c * r2 + 1.0 / 40320.0; c = c * r2 - 1.0 / 720.0; c = c * r2 + 1.0 / 24.0; c = c * r2 - 0.5; c = c * r2 + 1.0;
    const int q = (int)((long long)kq & 3);
    const double ss = (q == 0) ? s : (q == 1) ? c : (q == 2) ? -s : -c, cc = (q == 0) ? c : (q == 1) ? -s : (q == 2) ? -c : s;
    sn = (float)ss; cs = (float)cc;
}
__device__ __forceinline__ float rope_freq(int j) { return (float)exp2(-(double)j * (13.287712379549449 / 128.0)); }

__device__ __forceinline__ void p0_prologue(const Params& p, LAS unsigned char* lds, int vcu, int G, int wave_s) {
    const int tid_o = opaque_tid(wave_s), lane = tid_o & 63, wave = wave_s;
    LAS float* scr = (LAS float*)(lds + wave * 16384);
    const int gw = vcu * NWAVES + wave, NGW = G * NWAVES;
    bf16_t* WIN = (bf16_t*)(p.ws + WS_WIN); bf16_t* WAR = (bf16_t*)(p.ws + WS_WAR); bf16_t* WO = (bf16_t*)(p.ws + WS_WO); bf16_t* WGU = (bf16_t*)(p.ws + WS_WGU); bf16_t* WD = (bf16_t*)(p.ws + WS_WD);
    constexpr int I_IN = 16 * (NIN / 32), I_A = 16 * 32, I_R = 32 * 32, I_O = 16 * 32, I_GU = 16 * (2 * DFF / 32), I_D = (DFF / 64) * 32;
    constexpr int NITEMS = I_IN + I_A + I_R + I_O + I_GU + I_D;
    for (int it = gw; it < NITEMS; it += NGW) {
        int r = it;
        if (r < I_IN) { const int nb = r % (NIN / 32), kb = r / (NIN / 32); p0_tr_item(p.w_in, NIN, 64 * kb, win_src_col(32 * nb), WIN, D, 32 * nb, 0, p.g_mix, scr, lane); continue; } r -= I_IN;
        if (r < I_A) { const int nb = r % 32, kb = r / 32; p0_tr_item(p.w_a_out, D, 64 * kb, 32 * nb, WAR, 3072, 32 * nb, 0, nullptr, scr, lane); continue; } r -= I_A;
        if (r < I_R) { const int nb = r % 32, kb = r / 32; p0_tr_item(p.w_r_out, D, 64 * kb, 32 * nb, WAR, 3072, 32 * nb, 1024, nullptr, scr, lane); continue; } r -= I_R;
        if (r < I_O) { const int nb = r % 32, kb = r / 32; p0_tr_item(p.w_o, D, 64 * kb, 32 * nb, WO, D, 32 * nb, 0, nullptr, scr, lane); continue; } r -= I_O;
        if (r < I_GU) { const int nb = r % (2 * DFF / 32), kb = r / (2 * DFF / 32); const int n0d = 32 * nb, t = n0d >> 8, i = n0d & 255;
            if (i < 128) p0_tr_item(p.w_ff_gate, DFF, 64 * kb, 128 * t + i, WGU, D, n0d, 0, p.g_ffn, scr, lane);
            else p0_tr_item(p.w_ff_up, DFF, 64 * kb, 128 * t + (i - 128), WGU, D, n0d, 0, p.g_ffn, scr, lane);
            continue; } r -= I_GU;
        { const int nb = r % 32, kb = r / 32; p0_tr_item(p.w_ff_down, D, 64 * kb, 32 * nb, WD, DFF, 32 * nb, 0, nullptr, scr, lane); }
    }
    bf16_t* XB = (bf16_t*)(p.ws + WS_XB); float* RSTD = (float*)(p.ws + WS_RSTD);
    for (int m = gw; m < M; m += NGW) {
        const f32x4* xr = (const f32x4*)(p.x + (size_t)m * D) + lane; f32x4 v[4]; float s = 0.f;
#pragma unroll
        for (int j = 0; j < 4; ++j) { v[j] = xr[64 * j]; s += (v[j].x * v[j].x + v[j].y * v[j].y) + (v[j].z * v[j].z + v[j].w * v[j].w); }
        s = wave_sum(s);
        if (lane == 0) RSTD[m] = 1.0f / sqrtf(s * (1.0f / D) + EPS);
        u32x2* o8 = (u32x2*)(XB + (size_t)m * D) + lane;
#pragma unroll
        for (int j = 0; j < 4; ++j) { u32x2 w; w.x = cvtpk(v[j].x, v[j].y); w.y = cvtpk(v[j].z, v[j].w); o8[64 * j] = w; }
    }
    float* CS = (float*)(p.ws + WS_ROPE); float* SN = CS + (size_t)SEQ * 128; float* CST = SN + (size_t)SEQ * 128; float* SNT = CST + (size_t)SEQ * 128;
    const int gt = gw * 64 + lane, NGT = NGW * 64;
    if (NGT == 131072) {
        { const int j = gt & 127; const float f = rope_freq(j);
          for (int pos = gt >> 7; pos < SEQ; pos += 1024) { float sn, cs; sincos_d((float)pos * f, sn, cs); CS[pos * 128 + j] = cs; SN[pos * 128 + j] = sn; } }
        { const int j = gt >> 10; const float f = rope_freq(j);
          for (int pos = gt & 1023; pos < SEQ; pos += 1024) { float sn, cs; sincos_d((float)pos * f, sn, cs); CST[j * SEQ + pos] = cs; SNT[j * SEQ + pos] = sn; } }
    } else {
        for (int i = gt; i < SEQ * 128; i += NGT) { const int pos = i >> 7, j = i & 127; float sn, cs; sincos_d((float)pos * rope_freq(j), sn, cs); CS[i] = cs; SN[i] = sn; }
        for (int i = gt; i < SEQ * 128; i += NGT) { const int j = i >> 13, pos = i & (SEQ - 1); float sn, cs; sincos_d((float)pos * rope_freq(j), sn, cs); CST[i] = cs; SNT[i] = sn; }
    }
}

constexpr int SC_VS = 0, SC_XI = 16384, SC_XI_PITCH = 528, SC_XI_BYTES = 32 * SC_XI_PITCH;
typedef u32x4 qset_t[16];
typedef u32x4 kset_t[2][8];

__device__ __forceinline__ void scan_vscale_store(LAS unsigned char* lds, int buf, int ks, int lane, const u32x4 v, const float (&z)[8]) {
    float f[8]; unpack8(v, f); u32x4 w;
    w.x = cvtpk(f[0] * z[0], f[1] * z[1]); w.y = cvtpk(f[2] * z[2], f[3] * z[3]); w.z = cvtpk(f[4] * z[4], f[5] * z[5]); w.w = cvtpk(f[6] * z[6], f[7] * z[7]);
    *(LAS u32x4*)(lds + SC_VS + buf * 8192 + ks * 1024 + lane * 16) = w;
}

struct ScanCtx {
    const bf16_t* QF; const bf16_t* KT; const bf16_t* VT; unsigned* R;
    int b, h, dir, es, lane;
    float lg;
};
__device__ __forceinline__ int scan_gc(const ScanCtx& c, int i) { return c.b * NCH + (c.dir ? (NCH - 1 - i) : i); }

template <int P, bool SECOND>
__device__ __forceinline__ void cross_step(const ScanCtx& c, LAS unsigned char* lds, int w, int i, const qset_t& qc, qset_t& qn, u32x4 (&vt)[2], const float (&zeta)[2][8], float xi_s) {
    const int lane = c.lane, r = lane & 31, hh = lane >> 5;
    const int gcc = scan_gc(c, i), gcn = scan_gc(c, (i + 1 < NCH) ? i + 1 : i), gcv = scan_gc(c, (i + 3 < NCH) ? i + 3 : NCH - 1);
    { const u32x4* src = (const u32x4*)(c.QF + ((((size_t)(gcn * 4 + c.h) * 4 + w) * 16) * 64) * 8) + lane;
#pragma unroll
      for (int kd = 0; kd < 16; ++kd) qn[kd] = src[kd * 64]; }
    unsigned* rp = c.R + ((((size_t)(gcc * 4 + c.h) * 16 + c.es) * 4 + w) * 2) * 256 + lane * 4;
    u32x4 pb0 = (u32x4){0u, 0u, 0u, 0u}, pb1 = (u32x4){0u, 0u, 0u, 0u};
    if (SECOND) { pb0 = *(const u32x4*)rp; pb1 = *(const u32x4*)(rp + 256); }
    __builtin_amdgcn_sched_barrier(0);
    f32x16 o;
#pragma unroll
    for (int k = 0; k < 16; ++k) o[k] = 0.f;
    const LAS unsigned char* xi = lds + SC_XI + P * SC_XI_BYTES + r * SC_XI_PITCH + hh * 16;
#pragma unroll
    for (int kd = 0; kd < 16; ++kd) {
        const bf16x8 a = *(const LAS bf16x8*)(xi + kd * 32);
        o = __builtin_amdgcn_mfma_f32_32x32x16_bf16(a, __builtin_bit_cast(bf16x8, qc[kd]), o, 0, 0, 0);
    }
#pragma unroll
    for (int k = 0; k < 16; ++k) o[k] *= xi_s;
    if (SECOND) {
        const unsigned pw[8] = {pb0.x, pb0.y, pb0.z, pb0.w, pb1.x, pb1.y, pb1.z, pb1.w};
#pragma unroll
        for (int k = 0; k < 8; ++k) { o[2 * k] += bflo(pw[k]); o[2 * k + 1] += bfhi(pw[k]); }
    }
    u32x4 w0, w1;
    w0.x = cvtpk(o[0], o[1]); w0.y = cvtpk(o[2], o[3]); w0.z = cvtpk(o[4], o[5]); w0.w = cvtpk(o[6], o[7]);
    w1.x = cvtpk(o[8], o[9]); w1.y = cvtpk(o[10], o[11]); w1.z = cvtpk(o[12], o[13]); w1.w = cvtpk(o[14], o[15]);
    *(u32x4*)rp = w0; *(u32x4*)(rp + 256) = w1;
    scan_vscale_store(lds, P ^ 1, 2 * w, lane, vt[0], zeta[0]);
    scan_vscale_store(lds, P ^ 1, 2 * w + 1, lane, vt[1], zeta[1]);
    { const u32x4* src = (const u32x4*)(c.VT + ((((size_t)(gcv * 4 + c.h) * 16 + c.es) * 8 + 2 * w) * 64) * 8) + lane; vt[0] = src[0]; vt[1] = src[64]; }
    __syncthreads();
}
template <bool SECOND>
__device__ __forceinline__ void cross_half(const ScanCtx& c, LAS unsigned char* lds, int w, int i0, qset_t& qa, qset_t& qb, u32x4 (&vt0)[2], u32x4 (&vt1)[2], const float (&zeta)[2][8], float xi_s) {
    for (int i = i0; i < i0 + NCH / 2; i += 2) {
        cross_step<0, SECOND>(c, lds, w, i, qa, qb, vt1, zeta, xi_s);
        cross_step<1, SECOND>(c, lds, w, i + 1, qb, qa, vt0, zeta, xi_s);
    }
}
__device__ __forceinline__ void cross_role(const ScanCtx& c, LAS unsigned char* lds, const XcdBarrier& bar, int w) {
    const int lane = c.lane, r = lane & 31, hh = lane >> 5;
    const int t = 32 * w + r; const float xi_s = exp2f((c.dir ? (float)(128 - t) : (float)(t + 1)) * c.lg);
    float zeta[2][8];
#pragma unroll
    for (int f = 0; f < 2; ++f)
#pragma unroll
        for (int j = 0; j < 8; ++j) { const int s = 16 * (2 * w + f) + 8 * (j >> 2) + 4 * hh + (j & 3); zeta[f][j] = exp2f((c.dir ? (float)s : (float)(127 - s)) * c.lg); }
    qset_t qa, qb; u32x4 vt0[2], vt1[2];
    const int g0 = scan_gc(c, 0), g1 = scan_gc(c, 1), g2 = scan_gc(c, 2);
    { const u32x4* src = (const u32x4*)(c.QF + ((((size_t)(g0 * 4 + c.h) * 4 + w) * 16) * 64) * 8) + lane;
#pragma unroll
      for (int kd = 0; kd < 16; ++kd) { qa[kd] = src[kd * 64]; qb[kd] = (u32x4){0u, 0u, 0u, 0u}; } }
    { const u32x4* src = (const u32x4*)(c.VT + ((((size_t)(g0 * 4 + c.h) * 16 + c.es) * 8 + 2 * w) * 64) * 8) + lane;
      scan_vscale_store(lds, 0, 2 * w, lane, src[0], zeta[0]); scan_vscale_store(lds, 0, 2 * w + 1, lane, src[64], zeta[1]); }
    { const u32x4* src = (const u32x4*)(c.VT + ((((size_t)(g1 * 4 + c.h) * 16 + c.es) * 8 + 2 * w) * 64) * 8) + lane; vt1[0] = src[0]; vt1[1] = src[64]; }
    { const u32x4* src = (const u32x4*)(c.VT + ((((size_t)(g2 * 4 + c.h) * 16 + c.es) * 8 + 2 * w) * 64) * 8) + lane; vt0[0] = src[0]; vt0[1] = src[64]; }
    __syncthreads();
    cross_half<false>(c, lds, w, 0, qa, qb, vt0, vt1, zeta, xi_s);
    xcd_barrier(bar);
    cross_half<true>(c, lds, w, NCH / 2, qa, qb, vt0, vt1, zeta, xi_s);
}

template <int P>
__device__ __forceinline__ void update_step(const ScanCtx& c, LAS unsigned char* lds, int w, int i, const kset_t& kc, kset_t& kn, f32x16 (&X)[2], float decay) {
    const int lane = c.lane, r = lane & 31, hh = lane >> 5;
    const int gcn = scan_gc(c, (i + 1 < NCH) ? i + 1 : i);
#pragma unroll
    for (int tI = 0; tI < 2; ++tI) { const u32x4* src = (const u32x4*)(c.KT + ((((size_t)(gcn * 4 + c.h) * 8 + 2 * w + tI) * 8) * 64) * 8) + lane;
#pragma unroll
        for (int ks = 0; ks < 8; ++ks) kn[tI][ks] = src[ks * 64]; }
    __builtin_amdgcn_sched_barrier(0);
#pragma unroll
    for (int k = 0; k < 16; ++k) { X[0][k] *= decay; X[1][k] *= decay; }
    const LAS unsigned char* vs = lds + SC_VS + P * 8192 + lane * 16;
#pragma unroll
    for (int ks = 0; ks < 8; ++ks) {
        const bf16x8 bv = *(const LAS bf16x8*)(vs + ks * 1024);
        X[0] = __builtin_amdgcn_mfma_f32_32x32x16_bf16(__builtin_bit_cast(bf16x8, kc[0][ks]), bv, X[0], 0, 0, 0);
        X[1] = __builtin_amdgcn_mfma_f32_32x32x16_bf16(__builtin_bit_cast(bf16x8, kc[1][ks]), bv, X[1], 0, 0, 0);
    }
    LAS unsigned char* xo = lds + SC_XI + (P ^ 1) * SC_XI_BYTES + r * SC_XI_PITCH;
#pragma unroll
    for (int tI = 0; tI < 2; ++tI)
#pragma unroll
        for (int g = 0; g < 4; ++g) { u32x2 pk; pk.x = cvtpk(X[tI][4 * g], X[tI][4 * g + 1]); pk.y = cvtpk(X[tI][4 * g + 2], X[tI][4 * g + 3]);
            *(LAS u32x2*)(xo + (32 * (2 * w + tI) + 8 * g + 4 * hh) * 2) = pk; }
    __syncthreads();
}
__device__ __forceinline__ void update_half(const ScanCtx& c, LAS unsigned char* lds, int w, int i0, kset_t& ka, kset_t& kb, f32x16 (&X)[2], float decay) {
    for (int i = i0; i < i0 + NCH / 2; i += 2) {
        update_step<0>(c, lds, w, i, ka, kb, X, decay);
        update_step<1>(c, lds, w, i + 1, kb, ka, X, decay);
    }
}
__device__ __forceinline__ void update_role(const ScanCtx& c, LAS unsigned char* lds, const XcdBarrier& bar, int w) {
    const int lane = c.lane; const float decay = exp2f(128.0f * c.lg);
    kset_t ka, kb; f32x16 X[2];
#pragma unroll
    for (int k = 0; k < 16; ++k) { X[0][k] = 0.f; X[1][k] = 0.f; }
    const int g0 = scan_gc(c, 0);
#pragma unroll
    for (int tI = 0; tI < 2; ++tI) { const u32x4* src = (const u32x4*)(c.KT + ((((size_t)(g0 * 4 + c.h) * 8 + 2 * w + tI) * 8) * 64) * 8) + lane;
#pragma unroll
        for (int ks = 0; ks < 8; ++ks) { ka[tI][ks] = src[ks * 64]; kb[tI][ks] = (u32x4){0u, 0u, 0u, 0u}; } }
    __syncthreads();
    update_half(c, lds, w, 0, ka, kb, X, decay);
    xcd_barrier(bar);
    update_half(c, lds, w, NCH / 2, ka, kb, X, decay);
}
__device__ __forceinline__ float log2_gamma(float logit) { return -log1pf(__expf(-logit)) * 1.44269504088896340736f; }

__device__ __forceinline__ void scan_phase(const Params& p, LAS unsigned char* lds, const XcdBarrier& bar, int wave_s) {
    const int tid_o = opaque_tid(wave_s), lane = tid_o & 63, wid = wave_s;
    const int item = blockIdx.x, bh = item & 7, sub = item >> 3;
    ScanCtx c; c.QF = (const bf16_t*)(p.ws + WS_QF); c.KT = (const bf16_t*)(p.ws + WS_KT); c.VT = (const bf16_t*)p.out; c.R = (unsigned*)(p.ws + WS_R);
    c.b = bh >> 2; c.h = bh & 3; c.dir = sub & 1; c.es = sub >> 1; c.lane = lane;
    c.lg = log2_gamma(c.dir ? p.dec_b[c.h] : p.dec_f[c.h]);
    for (int o = tid_o * 16; o < SC_XI_BYTES; o += NTHREADS * 16) *(LAS u32x4*)(lds + SC_XI + o) = (u32x4){0u, 0u, 0u, 0u};
    if (wid < 4) cross_role(c, lds, bar, wid); else update_role(c, lds, bar, wid - 4);
}

constexpr int P3_STAT = 65536;
__device__ __forceinline__ void intra_phase(const Params& p, LAS unsigned char* lds, int wave_s) {
    const int tid_o = opaque_tid(wave_s), lane = tid_o & 63, wid = wave_s;
    const bf16_t* QF = (const bf16_t*)(p.ws + WS_QF); const bf16_t* KF = (const bf16_t*)(p.ws + WS_KF); const bf16_t* VT = (const bf16_t*)p.out;
    unsigned* R = (unsigned*)(p.ws + WS_R);
    const int tt = wid & 3, eh = wid >> 2;
    LAS float* stat = (LAS float*)(lds + P3_STAT);
    for (int item = blockIdx.x; item < NGC * NH; item += gridDim.x) {
        const int gc = item >> 2, h = item & 3;
        int lane_o = lane; asm volatile("" : "+v"(lane_o));
        const int lane = lane_o, r = lane & 31, hh = lane >> 5;
        const float lgf = log2_gamma(p.dec_f[h]), lgb = log2_gamma(p.dec_b[h]);
        u32x4 qf[16];
        { const u32x4* src = (const u32x4*)(QF + ((((size_t)(gc * 4 + h) * 4 + tt) * 16) * 64) * 8) + lane;
#pragma unroll
          for (int kd = 0; kd < 16; ++kd) qf[kd] = src[kd * 64]; }
        LAS unsigned char* xbl = lds + wid * 8192;
#pragma unroll
        for (int st = 0; st < 4; ++st) {
            f32x16 sacc;
#pragma unroll
            for (int k = 0; k < 16; ++k) sacc[k] = 0.f;
            const u32x4* ksrc = (const u32x4*)(KF + ((((size_t)(gc * 4 + h) * 4 + st) * 16) * 64) * 8) + lane;
#pragma unroll
            for (int kd = 0; kd < 16; ++kd) { const u32x4 kf = ksrc[kd * 64];
                sacc = __builtin_amdgcn_mfma_f32_32x32x16_bf16(__builtin_bit_cast(bf16x8, kf), __builtin_bit_cast(bf16x8, qf[kd]), sacc, 0, 0, 0);
                if ((kd & 3) == 3) asm volatile("" ::: "memory"); }
            const int t = 32 * tt + r;
#pragma unroll
            for (int k = 0; k < 16; ++k) { const int s = 32 * st + (k & 3) + 8 * (k >> 2) + 4 * hh; const int df = t - s;
                const float dec = (df >= 0) ? exp2f((float)df * lgf) : exp2f((float)(-df) * lgb); sacc[k] *= dec; }
            u32x4 x0, x1;
            x0.x = cvtpk(sacc[0], sacc[1]); x0.y = cvtpk(sacc[2], sacc[3]); x0.z = cvtpk(sacc[4], sacc[5]); x0.w = cvtpk(sacc[6], sacc[7]);
            x1.x = cvtpk(sacc[8], sacc[9]); x1.y = cvtpk(sacc[10], sacc[11]); x1.z = cvtpk(sacc[12], sacc[13]); x1.w = cvtpk(sacc[14], sacc[15]);
            *(LAS u32x4*)(xbl + (st * 2) * 1024 + lane * 16) = x0; *(LAS u32x4*)(xbl + (st * 2 + 1) * 1024 + lane * 16) = x1;
            asm volatile("" ::: "memory");
        }
        f32x16 o[8];
#pragma unroll
        for (int et8 = 0; et8 < 8; ++et8) {
            const int et = eh * 8 + et8;
#pragma unroll
            for (int k = 0; k < 16; ++k) o[et8][k] = 0.f;
            const u32x4* vsrc = (const u32x4*)(VT + ((((size_t)(gc * 4 + h) * 16 + et) * 8) * 64) * 8) + lane;
#pragma unroll
            for (int ks = 0; ks < 8; ++ks) { const u32x4 vf = vsrc[ks * 64];
                const bf16x8 xf = *(const LAS bf16x8*)(xbl + ks * 1024 + lane * 16);
                o[et8] = __builtin_amdgcn_mfma_f32_32x32x16_bf16(__builtin_bit_cast(bf16x8, vf), xf, o[et8], 0, 0, 0);
                if (ks == 3) asm volatile("" ::: "memory"); }
            const unsigned* rp = R + ((((size_t)(gc * 4 + h) * 16 + et) * 4 + tt) * 2) * 256 + lane * 4;
            const u32x4 b0 = *(const u32x4*)rp, b1 = *(const u32x4*)(rp + 256);
            const unsigned pw[8] = {b0.x, b0.y, b0.z, b0.w, b1.x, b1.y, b1.z, b1.w};
#pragma unroll
            for (int k = 0; k < 8; ++k) { o[et8][2 * k] += bflo(pw[k]); o[et8][2 * k + 1] += bfhi(pw[k]); }
            asm volatile("" ::: "memory"); __builtin_amdgcn_sched_barrier(0);
        }
        float s1 = 0.f;
#pragma unroll
        for (int et8 = 0; et8 < 8; ++et8)
#pragma unroll
            for (int k = 0; k < 16; ++k) s1 += o[et8][k];
        s1 += __shfl_xor(s1, 32);
        if (hh == 0) stat[eh * 128 + 32 * tt + r] = s1;
        __syncthreads();
        const float mean = (stat[32 * tt + r] + stat[128 + 32 * tt + r]) * (1.0f / DV);
        float s2 = 0.f;
#pragma unroll
        for (int et8 = 0; et8 < 8; ++et8)
#pragma unroll
            for (int k = 0; k < 16; ++k) { const float d = o[et8][k] - mean; s2 += d * d; }
        s2 += __shfl_xor(s2, 32);
        if (hh == 0) stat[256 + eh * 128 + 32 * tt + r] = s2;
        __syncthreads();
        const float rstd = 1.0f / sqrtf((stat[256 + 32 * tt + r] + stat[256 + 128 + 32 * tt + r]) * (1.0f / DV) + EPS);
        bf16_t* ZB = (bf16_t*)R;
        int lane_s = lane; asm volatile("" : "+v"(lane_s)); const int r_s = lane_s & 31, hh_s = lane_s >> 5;
#pragma unroll
        for (int et8 = 0; et8 < 8; ++et8) {
            const int et = eh * 8 + et8;
            bf16_t* zt = ZB + (((size_t)(gc * 64 + h * 16 + et) * 4 + tt) * 1024) + r_s * 32;
#pragma unroll
            for (int g = 0; g < 4; ++g) {
                const f32x4 gr = *(const f32x4*)(p.g_ret + h * DV + 32 * et + 8 * g + 4 * hh_s);
                u32x2 pk; pk.x = cvtpk((o[et8][4 * g] - mean) * rstd * gr[0], (o[et8][4 * g + 1] - mean) * rstd * gr[1]);
                pk.y = cvtpk((o[et8][4 * g + 2] - mean) * rstd * gr[2], (o[et8][4 * g + 3] - mean) * rstd * gr[3]);
                *(u32x2*)(zt + 8 * g + 4 * hh_s) = pk;
            }
            asm volatile("" ::: "memory"); __builtin_amdgcn_sched_barrier(0);
        }
        __syncthreads();
    }
}

__device__ __forceinline__ void final_phase(const Params& p, int vcu, int G, int wave_s) {
    const int tid_o = opaque_tid(wave_s), lane = tid_o & 63, wave = wave_s;
    const float* SS2 = (const float*)(p.ws + WS_SS2);
    const int gw = vcu * NWAVES + wave, NGW = G * NWAVES;
    for (int m = gw; m < M; m += NGW) {
        float ss = (lane < 16) ? SS2[(size_t)m * 16 + lane] : 0.f; ss = wave_sum(ss);
        const float rs = 1.0f / sqrtf(ss * (1.0f / D) + EPS);
        f32x4* xr = (f32x4*)(p.out + (size_t)m * D) + lane; const f32x4* gr = (const f32x4*)p.g_final + lane;
#pragma unroll
        for (int j = 0; j < 4; ++j) { const f32x4 v = xr[64 * j], g = gr[64 * j]; xr[64 * j] = v * rs * g; }
    }
}

__global__ void __launch_bounds__(NTHREADS, 2) fwd_kernel(Params p) {
    extern __shared__ __attribute__((aligned(16))) unsigned char lds_raw[];
    LAS unsigned char* lds = (LAS unsigned char*)lds_raw;
    volatile LAS unsigned* MISC = (volatile LAS unsigned*)(lds + LDS_MISC);
    const int tid = threadIdx.x, wave_s = __builtin_amdgcn_readfirstlane(tid >> 6);
    const int G = gridDim.x, bx = blockIdx.x, vcu = (G % 8 == 0) ? (bx % 8) * (G / 8) + bx / 8 : bx;
    if (tid < 64) MISC[tid] = 0u;
    __syncthreads();
    unsigned* ctl = (unsigned*)(p.ws + WS_CTL);
    XcdBarrier bar = xcd_barrier_post(ctl + CW_BAR, MISC + 8, wave_s);
    unsigned char* ws = p.ws;
    bf16_t* WIN = (bf16_t*)(ws + WS_WIN); const float* RSTD = (const float*)(ws + WS_RSTD);
    const float* CS = (const float*)(ws + WS_ROPE); const float* SN = CS + (size_t)SEQ * 128; const float* CST = SN + (size_t)SEQ * 128; const float* SNT = CST + (size_t)SEQ * 128;
    bf16_t* XB = (bf16_t*)(ws + WS_XB);

    p0_prologue(p, lds, vcu, G, wave_s);
    xcd_barrier(bar);
    { pg8::Gemm g{XB, D, 16, nullptr, WIN, M, 2048, D}; pg8::StaticOrder S; S.init(M, 2048, G, bx);
      EpiQK E{(bf16_t*)(ws + WS_QF), (bf16_t*)(ws + WS_KF), RSTD, CS, SN};
      pg8::gemm_phase(lds, g, S, E, wave_s); }
    { pg8::Gemm g{WIN + (size_t)1024 * D, D, 16, nullptr, XB, 3072, M, D}; pg8::StaticOrder S; S.init(3072, M, G, bx);
      EpiKVT E{(bf16_t*)(ws + WS_KT), (bf16_t*)p.out, RSTD, CST, SNT};
      pg8::gemm_phase(lds, g, S, E, wave_s); }
    xcd_barrier(bar);
    scan_phase(p, lds, bar, wave_s);
    xcd_barrier(bar);
    intra_phase(p, lds, wave_s);
    { pg8::Gemm g{XB, D, 16, nullptr, WIN + (size_t)4096 * D, M, 2048, D}; pg8::StaticOrder S; S.init(M, 2048, G, bx);
      EpiU E{(bf16_t*)(ws + WS_U), RSTD};
      pg8::gemm_phase(lds, g, S, E, wave_s); }
    xcd_barrier(bar);
    { pg8::Gemm g{XB, D, 16, nullptr, WIN + (size_t)6144 * D, M, 5120, D}; pg8::StaticOrder S; S.init(M, 5120, G, bx);
      EpiB E{(const bf16_t*)(ws + WS_U), (bf16_t*)(ws + WS_A1), (bf16_t*)(ws + WS_R), (bf16_t*)p.out, RSTD, p.w_conv};
      pg8::gemm_phase(lds, g, S, E, wave_s); }
    xcd_barrier(bar);
    { pg8::Gemm g{(const bf16_t*)(ws + WS_A1), D, 16, (const bf16_t*)(ws + WS_R), (const bf16_t*)(ws + WS_WAR), M, D, 3072}; pg8::StaticOrder S; S.init(M, D, G, bx);
      EpiMerge E{(const bf16_t*)p.out, (bf16_t*)(ws + WS_MG)};
      pg8::gemm_phase(lds, g, S, E, wave_s); }
    xcd_barrier(bar);
    { pg8::Gemm g{(const bf16_t*)(ws + WS_MG), D, 16, nullptr, (const bf16_t*)(ws + WS_WO), M, D, D}; pg8::StaticOrder S; S.init(M, D, G, bx);
      EpiRes<true> E{p.x, p.out, (bf16_t*)(ws + WS_X1B), (float*)(ws + WS_SS1)};
      pg8::gemm_phase(lds, g, S, E, wave_s); }
    xcd_barrier(bar);
    { pg8::Gemm g{(const bf16_t*)(ws + WS_X1B), D, 16, nullptr, (const bf16_t*)(ws + WS_WGU), M, 2 * DFF, D}; pg8::StaticOrder S; S.init(M, 2 * DFF, G, bx);
      EpiGU E{(bf16_t*)(ws + WS_ACT), (const float*)(ws + WS_SS1)};
      pg8::gemm_phase(lds, g, S, E, wave_s); }
    xcd_barrier(bar);
    { pg8::Gemm g{(const bf16_t*)(ws + WS_ACT), DFF, DFF / 64, nullptr, (const bf16_t*)(ws + WS_WD), M, D, DFF}; pg8::StaticOrder S; S.init(M, D, G, bx);
      EpiRes<false> E{p.out, p.out, nullptr, (float*)(ws + WS_SS2)};
      pg8::gemm_phase(lds, g, S, E, wave_s); }
    xcd_barrier(bar);
    final_phase(p, vcu, G, wave_s);
}

extern "C" void kernel_launch(void* const* d_in, const int* in_sizes, int n_in, void* d_out, int out_size, void* d_ws, size_t ws_size, hipStream_t stream) {
    static int grid = 0;
    if (grid == 0) {
        if (n_in != 15 || in_sizes[0] != M * D || out_size != M * D || ws_size < WS_END) { fprintf(stderr, "kernel_launch: unexpected shapes (n_in %d, in0 %d, out %d, ws %zu)\n", n_in, n_in > 0 ? in_sizes[0] : -1, out_size, ws_size); grid = -1; return; }
        int dev = 0, cus = 0, per_cu = 0;
        if (hipGetDevice(&dev) != hipSuccess || hipDeviceGetAttribute(&cus, hipDeviceAttributeMultiprocessorCount, dev) != hipSuccess) { grid = -1; return; }
        if (hipFuncSetAttribute((const void*)fwd_kernel, hipFuncAttributeMaxDynamicSharedMemorySize, LDS_BYTES) != hipSuccess) { fprintf(stderr, "kernel_launch: hipFuncSetAttribute failed\n"); grid = -1; return; }
        if (hipOccupancyMaxActiveBlocksPerMultiprocessor(&per_cu, (const void*)fwd_kernel, NTHREADS, LDS_BYTES) != hipSuccess || per_cu < 1) fprintf(stderr, "kernel_launch: occupancy query reports %d\n", per_cu);
        (void)hipGetLastError();
        grid = cus;
        if (grid != 256) { fprintf(stderr, "kernel_launch: this kernel needs a 256-CU device (got %d)\n", cus); grid = -1; return; }
    }
    if (grid < 0) return;
    if (hipMemsetAsync((char*)d_ws + WS_CTL, 0, CTL_ZERO_BYTES, stream) != hipSuccess) return;
    Params p{};
    p.x = (const float*)d_in[0]; p.g_mix = (const float*)d_in[1]; p.w_in = (const float*)d_in[2]; p.w_conv = (const float*)d_in[3]; p.dec_f = (const float*)d_in[4]; p.dec_b = (const float*)d_in[5];
    p.g_ret = (const float*)d_in[6]; p.w_a_out = (const float*)d_in[7]; p.w_r_out = (const float*)d_in[8]; p.w_o = (const float*)d_in[9]; p.g_ffn = (const float*)d_in[10];
    p.w_ff_gate = (const float*)d_in[11]; p.w_ff_up = (const float*)d_in[12]; p.w_ff_down = (const float*)d_in[13]; p.g_final = (const float*)d_in[14];
    p.out = (float*)d_out; p.ws = (unsigned char*)d_ws;
    hipLaunchKernelGGL(fwd_kernel, dim3(grid), dim3(NTHREADS), LDS_BYTES, stream, p);
}
```
